# Optimizing an MI355X kernel written in HIP

```python
import math
import jax, jax.numpy as jnp
from jax import lax
import numpy as np

D_MODEL = 4096
BATCH = 4
SEQ = 4096
DEPTH = 2

N_MIXERS = 2
N_S5_LAYERS = (DEPTH + 1) // 2
N_ATTN_LAYERS = DEPTH // 2

S5_GROUP = 16
S5_GROUPS = D_MODEL // S5_GROUP
S5_STATE = 64
DT_MIN = 1e-3
DT_MAX = 1e-1

HEAD_DIM = 64
N_Q_HEADS = D_MODEL // HEAD_DIM
N_KV_HEADS = 8
Q_PER_KV = N_Q_HEADS // N_KV_HEADS
WINDOW = 128
BLOCK = 128
ROPE_THETA = 10000.0
Q_WIDTH = N_Q_HEADS * HEAD_DIM
KV_WIDTH = N_KV_HEADS * HEAD_DIM

D_FF = -(-8 * D_MODEL // (3 * 256)) * 256

EPS = 1e-6

kernel_name = "s5_swa_sink_hybrid_sandwich"


def rms_norm(x, g):
    xf = x.astype(jnp.float32)
    y = xf * lax.rsqrt(jnp.mean(xf * xf, axis=-1, keepdims=True) + EPS)
    return (y * g.astype(jnp.float32)).astype(x.dtype)


def s5_mixer(h, lam_re, lam_im, log_step, b_re, b_im, c_re, c_im, d_skip,
             w_out1, b_out1, w_out2, b_out2):
    f32 = jnp.float32
    bsz, seq, _ = h.shape
    hf = h.astype(f32)
    u = hf.reshape(bsz, seq, S5_GROUPS, S5_GROUP).astype(jnp.complex64)
    lam = lax.complex(lam_re.astype(f32), lam_im.astype(f32))
    step = jnp.exp(log_step.astype(f32))[:, None]
    lam_bar = jnp.exp(lam * step)
    b = lax.complex(b_re.astype(f32), b_im.astype(f32))
    b_bar = ((lam_bar - 1.0) / lam)[..., None] * b
    bu = jnp.einsum('gpc,blgc->blgp', b_bar, u)
    a = jnp.broadcast_to(lam_bar, bu.shape)

    def combine(left, right):
        a_l, b_l = left
        a_r, b_r = right
        return a_r * a_l, a_r * b_l + b_r

    _, states = lax.associative_scan(combine, (a, bu), axis=1)
    c = lax.complex(c_re.astype(f32), c_im.astype(f32))
    y = jnp.einsum('gcp,blgp->blgc', c, states).real.reshape(bsz, seq, D_MODEL)
    y = y + d_skip.astype(f32) * hf
    g = jax.nn.gelu(y).astype(h.dtype)
    return (g @ w_out1 + b_out1) * jax.nn.sigmoid(g @ w_out2 + b_out2)


def rope(x, positions):
    half = HEAD_DIM // 2
    inv_freq = jnp.power(ROPE_THETA, -jnp.arange(half, dtype=jnp.float32) / half)
    ang = positions.astype(jnp.float32)[..., None] * inv_freq
    cos = jnp.cos(ang)[:, :, None, :]
    sin = jnp.sin(ang)[:, :, None, :]
    xf = x.astype(jnp.float32)
    x1, x2 = xf[..., :half], xf[..., half:]
    return jnp.concatenate([x1 * cos - x2 * sin, x2 * cos + x1 * sin], axis=-1).astype(x.dtype)


def swa_mixer(h, positions, w_qkv, b_qkv, w_o, b_o, sinks):
    bsz, seq, _ = h.shape
    nblk = seq // BLOCK
    qkv = h @ w_qkv + b_qkv
    q, k, v = jnp.split(qkv, [Q_WIDTH, Q_WIDTH + KV_WIDTH], axis=-1)
    q = rope(q.reshape(bsz, seq, N_Q_HEADS, HEAD_DIM), positions)
    k = rope(k.reshape(bsz, seq, N_KV_HEADS, HEAD_DIM), positions)
    v = v.reshape(bsz, seq, N_KV_HEADS, HEAD_DIM)
    qb = q.reshape(bsz, nblk, BLOCK, N_KV_HEADS, Q_PER_KV, HEAD_DIM)

    def band(t):
        tb = t.reshape(bsz, nblk, BLOCK, N_KV_HEADS, HEAD_DIM)
        prev = jnp.pad(tb[:, :-1], ((0, 0), (1, 0), (0, 0), (0, 0), (0, 0)))
        return jnp.concatenate([prev, tb], axis=2)

    kb, vb = band(k), band(v)
    scores = jnp.einsum('bnqkgd,bnskd->bnkgqs', qb, kb).astype(jnp.float32) * (HEAD_DIM ** -0.5)
    qi = jnp.arange(BLOCK)[:, None]
    si = jnp.arange(2 * BLOCK)[None, :]
    diff = BLOCK + qi - si
    band_ok = (diff >= 0) & (diff < WINDOW)
    blk = jnp.arange(nblk)[:, None, None]
    in_seq = (blk * BLOCK - BLOCK + si[None]) >= 0
    mask = band_ok[None] & in_seq
    scores = jnp.where(mask[None, :, None, None], scores, -jnp.inf)
    sink = jnp.broadcast_to(
        sinks.astype(jnp.float32).reshape(1, 1, N_KV_HEADS, Q_PER_KV, 1, 1),
        scores.shape[:-1] + (1,))
    probs = jax.nn.softmax(jnp.concatenate([scores, sink], axis=-1), axis=-1)[..., :-1]
    out = jnp.einsum('bnkgqs,bnskd->bnqkgd', probs.astype(v.dtype), vb)
    out = out.reshape(bsz, seq, Q_WIDTH)
    return out @ w_o + b_o


def swiglu(h, w_gate, w_up, w_down):
    return (jax.nn.silu(h @ w_gate) * (h @ w_up)) @ w_down


def setup_inputs(seed: int = 0) -> dict:
    key = jax.random.key(seed)
    ks = jax.random.split(key, 32)
    f32 = jnp.float32

    def nrm(k, shape, scale):
        return jax.random.normal(k, shape, f32) * scale

    x = jax.random.normal(ks[0], (BATCH, SEQ, D_MODEL), f32)
    offsets = jax.random.randint(ks[1], (BATCH, 1), 0, 1024, dtype=jnp.int32)
    positions = (offsets + jnp.arange(SEQ, dtype=jnp.int32)[None, :]).astype(jnp.int32)

    norm_pre_mix = 1.0 + nrm(ks[2], (DEPTH, D_MODEL), 0.02)
    norm_post_mix = 1.0 + nrm(ks[3], (DEPTH, D_MODEL), 0.02)
    norm_pre_ffn = 1.0 + nrm(ks[4], (DEPTH, D_MODEL), 0.02)
    norm_post_ffn = 1.0 + nrm(ks[5], (DEPTH, D_MODEL), 0.02)

    ns = N_S5_LAYERS
    n_idx = jnp.arange(S5_STATE, dtype=f32)
    s5_lam_re = -0.5 + nrm(ks[6], (ns, S5_GROUPS, S5_STATE), 0.01)
    s5_lam_im = math.pi * n_idx + nrm(ks[7], (ns, S5_GROUPS, S5_STATE), 0.01)
    s5_log_step = jax.random.uniform(ks[8], (ns, S5_GROUPS), f32,
                                     math.log(DT_MIN), math.log(DT_MAX))
    s5_b_re = nrm(ks[9], (ns, S5_GROUPS, S5_STATE, S5_GROUP), (2 * S5_GROUP) ** -0.5)
    s5_b_im = nrm(ks[10], (ns, S5_GROUPS, S5_STATE, S5_GROUP), (2 * S5_GROUP) ** -0.5)
    s5_c_re = nrm(ks[11], (ns, S5_GROUPS, S5_GROUP, S5_STATE), (2 * S5_STATE) ** -0.5)
    s5_c_im = nrm(ks[12], (ns, S5_GROUPS, S5_GROUP, S5_STATE), (2 * S5_STATE) ** -0.5)
    s5_d = nrm(ks[13], (ns, D_MODEL), 1.0)
    s5_w_out1 = nrm(ks[14], (ns, D_MODEL, D_MODEL), D_MODEL ** -0.5)
    s5_b_out1 = nrm(ks[15], (ns, D_MODEL), 0.01)
    s5_w_out2 = nrm(ks[16], (ns, D_MODEL, D_MODEL), D_MODEL ** -0.5)
    s5_b_out2 = nrm(ks[17], (ns, D_MODEL), 0.01)

    na = N_ATTN_LAYERS
    attn_w_qkv = nrm(ks[18], (na, D_MODEL, Q_WIDTH + 2 * KV_WIDTH), D_MODEL ** -0.5)
    attn_b_qkv = nrm(ks[19], (na, Q_WIDTH + 2 * KV_WIDTH), 0.01)
    attn_w_o = nrm(ks[20], (na, Q_WIDTH, D_MODEL), Q_WIDTH ** -0.5)
    attn_b_o = nrm(ks[21], (na, D_MODEL), 0.01)
    attn_sinks = nrm(ks[22], (na, N_Q_HEADS), 0.5)

    ffn_w_gate = nrm(ks[23], (DEPTH, D_MODEL, D_FF), D_MODEL ** -0.5)
    ffn_w_up = nrm(ks[24], (DEPTH, D_MODEL, D_FF), D_MODEL ** -0.5)
    ffn_w_down = nrm(ks[25], (DEPTH, D_FF, D_MODEL), D_FF ** -0.5)

    return {
        "x": x, "positions": positions,
        "norm_pre_mix": norm_pre_mix, "norm_post_mix": norm_post_mix,
        "norm_pre_ffn": norm_pre_ffn, "norm_post_ffn": norm_post_ffn,
        "s5_lam_re": s5_lam_re, "s5_lam_im": s5_lam_im, "s5_log_step": s5_log_step,
        "s5_b_re": s5_b_re, "s5_b_im": s5_b_im, "s5_c_re": s5_c_re, "s5_c_im": s5_c_im,
        "s5_d": s5_d, "s5_w_out1": s5_w_out1, "s5_b_out1": s5_b_out1,
        "s5_w_out2": s5_w_out2, "s5_b_out2": s5_b_out2,
        "attn_w_qkv": attn_w_qkv, "attn_b_qkv": attn_b_qkv,
        "attn_w_o": attn_w_o, "attn_b_o": attn_b_o, "attn_sinks": attn_sinks,
        "ffn_w_gate": ffn_w_gate, "ffn_w_up": ffn_w_up, "ffn_w_down": ffn_w_down,
    }


def reference(x, positions, norm_pre_mix, norm_post_mix, norm_pre_ffn, norm_post_ffn,
              s5_lam_re, s5_lam_im, s5_log_step, s5_b_re, s5_b_im, s5_c_re, s5_c_im,
              s5_d, s5_w_out1, s5_b_out1, s5_w_out2, s5_b_out2,
              attn_w_qkv, attn_b_qkv, attn_w_o, attn_b_o, attn_sinks,
              ffn_w_gate, ffn_w_up, ffn_w_down):
    h = x
    for i in range(DEPTH):
        j = i // N_MIXERS
        hn = rms_norm(h, norm_pre_mix[i])
        if i % N_MIXERS == 0:
            m = s5_mixer(hn, s5_lam_re[j], s5_lam_im[j], s5_log_step[j],
                         s5_b_re[j], s5_b_im[j], s5_c_re[j], s5_c_im[j], s5_d[j],
                         s5_w_out1[j], s5_b_out1[j], s5_w_out2[j], s5_b_out2[j])
        else:
            m = swa_mixer(hn, positions, attn_w_qkv[j], attn_b_qkv[j],
                          attn_w_o[j], attn_b_o[j], attn_sinks[j])
        h = h + rms_norm(m, norm_post_mix[i])
        f = swiglu(rms_norm(h, norm_pre_ffn[i]), ffn_w_gate[i], ffn_w_up[i], ffn_w_down[i])
        h = h + rms_norm(f, norm_post_ffn[i])
    return h
```

```cpp
#include <hip/hip_runtime.h>
#include <cstdio>
#include <cstdint>

namespace pg8 {
#define PG8_LAS __attribute__((address_space(3)))
typedef unsigned short bf16_t;
typedef short bf16x8 __attribute__((ext_vector_type(8)));
typedef float f32x4 __attribute__((ext_vector_type(4)));
typedef unsigned u32x4 __attribute__((ext_vector_type(4)));
constexpr int BM = 256, BK = 64, HALF = 128, HTB = HALF * BK * 2, STAGE_BYTES = 8 * HTB, NXCD = 8, WGM = 8;

__host__ __device__ __forceinline__ int lds_byte(int r, int c) { const int st = (r >> 4) * 2 + (c >> 5), rr = r & 15, cc = c & 31, ob = rr * 64 + cc * 2; return st * 1024 + (ob ^ (((ob >> 9) & 1) << 5)); }
__host__ __device__ __forceinline__ void stage_rc(int b, int& R, int& C) { const int st = b / 1024, sb = b % 1024, swz = sb ^ (((sb >> 9) & 1) << 5); R = (st >> 1) * 16 + swz / 64; C = (st & 1) * 32 + (swz % 64) / 2; }
__host__ __device__ __forceinline__ int perm32(int rho) { const int n = rho >> 4, i = rho & 15; return 8 * (i >> 2) + 4 * n + (i & 3); }

struct Unit { int pm, pn; };
struct Gemm { const bf16_t* A; const bf16_t* Bt; int M, N, K; };

struct StaticOrder {
    int nM, nN, nwg, G, c;
    __host__ __device__ void init(int M, int N, int G_, int c_) { nM = M / BM; nN = N / BM; nwg = nM * nN; G = G_; c = c_; }
    __host__ __device__ bool next(int i, Unit& u) const {
        const long L = (long)i * G + c; if (L >= nwg) return false;
        int wgid = (int)L; { const int q = nwg / NXCD, r = nwg % NXCD, xcd = wgid % NXCD, off = wgid / NXCD; wgid = (xcd < r ? xcd * (q + 1) : r * (q + 1) + (xcd - r) * q) + off; }
        const int nig = WGM * nN, gid = wgid / nig, fm = gid * WGM, gsz = (nM - fm) < WGM ? (nM - fm) : WGM;
        u.pm = fm + ((wgid % nig) % gsz); u.pn = (wgid % nig) / gsz; return true;
    }
    __device__ __forceinline__ void a_ready(const Unit&) const {}
    __device__ __forceinline__ void done(const Unit&) const {}
};

__device__ __forceinline__ unsigned cvt_pk_bf16(float lo, float hi) { unsigned r; asm volatile("v_cvt_pk_bf16_f32 %0, %1, %2" : "=v"(r) : "v"(lo), "v"(hi)); return r; }


struct EpiPlain {
    static constexpr bool PERM = true, AFTER_DRAIN = false;
    bf16_t* O; int ldc; const float* bias;
    __device__ __forceinline__ void operator()(const f32x4 (&acc)[2][2][4][2], const Unit& u, int wr, int wc, int fr, int fq) const {
        const int row0 = u.pm * BM + wr * 64 + fr; const int col0 = u.pn * BM + wc * 32 + 8 * fq;
        f32x4 bv[2][2];
#pragma unroll
        for (int bj = 0; bj < 2; ++bj)
#pragma unroll
            for (int n = 0; n < 2; ++n) bv[bj][n] = bias ? *(const f32x4*)(bias + col0 + bj * HALF + 4 * n) : (f32x4){0.f, 0.f, 0.f, 0.f};
#pragma unroll
        for (int ai = 0; ai < 2; ++ai)
#pragma unroll
            for (int m = 0; m < 4; ++m) { bf16_t* rowp = O + (size_t)(row0 + ai * HALF + m * 16) * ldc + col0;
#pragma unroll
                for (int bj = 0; bj < 2; ++bj) { const f32x4 v0 = acc[ai][bj][m][0] + bv[bj][0], v1 = acc[ai][bj][m][1] + bv[bj][1];
                    u32x4 w; w.x = cvt_pk_bf16(v0[0], v0[1]); w.y = cvt_pk_bf16(v0[2], v0[3]); w.z = cvt_pk_bf16(v1[0], v1[1]); w.w = cvt_pk_bf16(v1[2], v1[3]);
                    *(u32x4*)(rowp + bj * HALF) = w; } }
    }
};
__device__ __forceinline__ float sigmoid_f(float x) { return __builtin_amdgcn_rcpf(1.0f + __builtin_amdgcn_exp2f(-1.4426950408889634f * x)); }
struct EpiGlu {
    static constexpr bool PERM = true, AFTER_DRAIN = false;
    bf16_t* O; int ldc; const float* b1; const float* b2;
    __device__ __forceinline__ void operator()(const f32x4 (&acc)[2][2][4][2], const Unit& u, int wr, int wc, int fr, int fq) const {
        const int row0 = u.pm * BM + wr * 64 + fr; const int col0 = u.pn * HALF + wc * 32 + 8 * fq;
        f32x4 bv[2][2];
#pragma unroll
        for (int n = 0; n < 2; ++n) { bv[0][n] = *(const f32x4*)(b1 + col0 + 4 * n); bv[1][n] = *(const f32x4*)(b2 + col0 + 4 * n); }
#pragma unroll
        for (int ai = 0; ai < 2; ++ai)
#pragma unroll
            for (int m = 0; m < 4; ++m) { bf16_t* rowp = O + (size_t)(row0 + ai * HALF + m * 16) * ldc + col0;
                f32x4 o[2];
#pragma unroll
                for (int n = 0; n < 2; ++n) { const f32x4 a = acc[ai][0][m][n] + bv[0][n], g = acc[ai][1][m][n] + bv[1][n];
#pragma unroll
                    for (int j = 0; j < 4; ++j) o[n][j] = a[j] * sigmoid_f(g[j]); }
                u32x4 w; w.x = cvt_pk_bf16(o[0][0], o[0][1]); w.y = cvt_pk_bf16(o[0][2], o[0][3]); w.z = cvt_pk_bf16(o[1][0], o[1][1]); w.w = cvt_pk_bf16(o[1][2], o[1][3]);
                *(u32x4*)rowp = w; }
    }
};
struct EpiSwiglu {
    static constexpr bool PERM = true, AFTER_DRAIN = false;
    bf16_t* O; int ldc; const float* rstd;
    __device__ __forceinline__ void operator()(const f32x4 (&acc)[2][2][4][2], const Unit& u, int wr, int wc, int fr, int fq) const {
        const int row0 = u.pm * BM + wr * 64 + fr; const int col0 = u.pn * HALF + wc * 32 + 8 * fq;
#pragma unroll
        for (int ai = 0; ai < 2; ++ai)
#pragma unroll
            for (int m = 0; m < 4; ++m) { const int row = row0 + ai * HALF + m * 16; const float rs = rstd[row]; bf16_t* rowp = O + (size_t)row * ldc + col0;
                f32x4 o[2];
#pragma unroll
                for (int n = 0; n < 2; ++n) { const f32x4 g = acc[ai][0][m][n] * rs, up = acc[ai][1][m][n] * rs;
#pragma unroll
                    for (int j = 0; j < 4; ++j) o[n][j] = g[j] * sigmoid_f(g[j]) * up[j]; }
                u32x4 w; w.x = cvt_pk_bf16(o[0][0], o[0][1]); w.y = cvt_pk_bf16(o[0][2], o[0][3]); w.z = cvt_pk_bf16(o[1][0], o[1][1]); w.w = cvt_pk_bf16(o[1][2], o[1][3]);
                *(u32x4*)rowp = w; }
    }
};
struct EpiQkv {
    static constexpr bool PERM = true, AFTER_DRAIN = false;
    bf16_t* Q; bf16_t* Kb; bf16_t* Vb; const float* rstd; const float* bias; const int* pos;
    __device__ __forceinline__ void operator()(const f32x4 (&acc)[2][2][4][2], const Unit& u, int wr, int wc, int fr, int fq) const {
        const int row0 = u.pm * BM + wr * 64 + fr; const int head = 4 * u.pn + wc;
        bf16_t* base; int ld, hcol;
        if (head < 64) { base = Q; ld = 4096; hcol = head * 64; } else if (head < 72) { base = Kb; ld = 512; hcol = (head - 64) * 64; } else { base = Vb; ld = 512; hcol = (head - 72) * 64; }
        const bool rope = head < 72;
        f32x4 bv[2][2];
#pragma unroll
        for (int bj = 0; bj < 2; ++bj)
#pragma unroll
            for (int n = 0; n < 2; ++n) bv[bj][n] = *(const f32x4*)(bias + head * 64 + 32 * bj + 8 * fq + 4 * n);
        float invf[2][4];
#pragma unroll
        for (int n = 0; n < 2; ++n)
#pragma unroll
            for (int j = 0; j < 4; ++j) invf[n][j] = exp2f(-(float)(8 * fq + 4 * n + j) * (13.287712379549449f / 32.0f));
#pragma unroll
        for (int ai = 0; ai < 2; ++ai)
#pragma unroll
            for (int m = 0; m < 4; ++m) { const int row = row0 + ai * HALF + m * 16; const float rs = rstd[row]; const float p = (float)pos[row];
                f32x4 v[2][2];
#pragma unroll
                for (int bj = 0; bj < 2; ++bj)
#pragma unroll
                    for (int n = 0; n < 2; ++n) v[bj][n] = acc[ai][bj][m][n] * rs + bv[bj][n];
                if (rope) {
#pragma unroll
                    for (int n = 0; n < 2; ++n)
#pragma unroll
                        for (int j = 0; j < 4; ++j) { const float ang = p * invf[n][j]; const float t = __builtin_amdgcn_fractf(ang * 0.15915494309189535f);
                            const float sn = __builtin_amdgcn_sinf(t), cs = __builtin_amdgcn_cosf(t); const float x1 = v[0][n][j], x2 = v[1][n][j];
                            v[0][n][j] = x1 * cs - x2 * sn; v[1][n][j] = x2 * cs + x1 * sn; }
                }
                bf16_t* rowp = base + (size_t)row * ld + hcol + 8 * fq;
#pragma unroll
                for (int bj = 0; bj < 2; ++bj) { u32x4 w; w.x = cvt_pk_bf16(v[bj][0][0], v[bj][0][1]); w.y = cvt_pk_bf16(v[bj][0][2], v[bj][0][3]); w.z = cvt_pk_bf16(v[bj][1][0], v[bj][1][1]); w.w = cvt_pk_bf16(v[bj][1][2], v[bj][1][3]);
                    *(u32x4*)(rowp + 32 * bj) = w; } }
    }
};

template <class Epi, class Sched, bool ALIGN_EPI = false, bool SP2 = false>
__device__ __forceinline__ void gemm_phase(PG8_LAS unsigned char* lds, const Gemm g, const Sched& S, const Epi& E) {
    const int tid = threadIdx.x, wid = __builtin_amdgcn_readfirstlane(tid >> 6), lane = tid & 63, wr = wid >> 2, wc = wid & 3, fr = lane & 15, fq = lane >> 4;
    const int K = g.K, nt = K / BK;
    unsigned voffA[2], voffB[2];
#pragma unroll
    for (int i = 0; i < 2; ++i) { int R, C; stage_rc(tid * 16 + i * 8192, R, C); const int Rb = Epi::PERM ? ((R & ~31) + perm32(R & 31)) : R;
        voffA[i] = (unsigned)(R * K + C) * 2u; voffB[i] = (unsigned)(Rb * K + C) * 2u; }
    const size_t kstep = (size_t)(BK * 2);
    const size_t hstep = (size_t)HALF * K * 2;
    const size_t tstep = 2 * hstep;
    const unsigned ldsw = (unsigned)wid * 1024u;
    const int aoff = lds_byte(wr * 64 + fr, fq * 8), boff = lds_byte(wc * 32 + fr, fq * 8);
#define PG8_SA(b, h) (((b) * 2 + (h)) * HTB)
#define PG8_SB(b, h) ((4 + (b) * 2 + (h)) * HTB)
#define PG8_STAGE(bufoff, gbase, voff) do { _Pragma("unroll") for (int _i = 0; _i < 2; ++_i) \
        __builtin_amdgcn_global_load_lds((const unsigned*)((const char*)(gbase) + (voff)[_i]), (PG8_LAS unsigned*)(lds + (bufoff) + ldsw + _i * 8192), 16, 0, 0); } while (0)
#define PG8_LDA(dst, b, h) do { _Pragma("unroll") for (int m = 0; m < 4; ++m) _Pragma("unroll") for (int k = 0; k < 2; ++k) dst[m][k] = *(const PG8_LAS bf16x8*)(lds + PG8_SA(b, h) + aoff + m * 2048 + k * 1024); } while (0)
#define PG8_LDB(dst, b, h) do { _Pragma("unroll") for (int n = 0; n < 2; ++n) _Pragma("unroll") for (int k = 0; k < 2; ++k) dst[n][k] = *(const PG8_LAS bf16x8*)(lds + PG8_SB(b, h) + boff + n * 2048 + k * 1024); } while (0)
#define PG8_MMA(ai, bj, At, Bt) do { __builtin_amdgcn_s_setprio(1); _Pragma("unroll") for (int m = 0; m < 4; ++m) _Pragma("unroll") for (int n = 0; n < 2; ++n) _Pragma("unroll") for (int k = 0; k < 2; ++k) \
        acc[ai][bj][m][n] = __builtin_amdgcn_mfma_f32_16x16x32_bf16(Bt[n][k], At[m][k], acc[ai][bj][m][n], 0, 0, 0); __builtin_amdgcn_s_setprio(0); } while (0)
#define PG8_WAIT_V(n) asm volatile("s_waitcnt vmcnt(" #n ")" ::: "memory")
#define PG8_WAIT_L(n) asm volatile("s_waitcnt lgkmcnt(" #n ")" ::: "memory")
#define PG8_BAR __builtin_amdgcn_s_barrier()
#define PG8_SCHED __builtin_amdgcn_sched_barrier(0)
    Unit cur, nxt; int ui = 0;
    if (!S.next(0, cur)) return;
    f32x4 acc[2][2][4][2];
#pragma unroll
    for (int a = 0; a < 2; ++a)
#pragma unroll
        for (int b = 0; b < 2; ++b)
#pragma unroll
            for (int m = 0; m < 4; ++m)
#pragma unroll
                for (int n = 0; n < 2; ++n) acc[a][b][m][n] = (f32x4){0.f, 0.f, 0.f, 0.f};
    bf16x8 At[4][2], B0[2][2], B1[2][2];
    const char* cA = (const char*)g.A + (size_t)cur.pm * tstep; const char* cB = (const char*)g.Bt + (size_t)cur.pn * tstep;
    S.a_ready(cur);
    if constexpr (SP2) {
        PG8_STAGE(PG8_SB(0, 0), cB, voffB); PG8_STAGE(PG8_SB(0, 1), cB + hstep, voffB); PG8_STAGE(PG8_SA(0, 0), cA, voffA); PG8_STAGE(PG8_SA(0, 1), cA + hstep, voffA);
        if (wr == 1) PG8_BAR;
        PG8_WAIT_V(2); PG8_BAR;
        PG8_STAGE(PG8_SB(1, 0), cB + kstep, voffB); PG8_STAGE(PG8_SA(1, 0), cA + kstep, voffA); PG8_STAGE(PG8_SB(1, 1), cB + hstep + kstep, voffB);
        PG8_WAIT_V(6); PG8_BAR;
    } else {
        PG8_STAGE(PG8_SB(0, 0), cB, voffB); PG8_STAGE(PG8_SA(0, 0), cA, voffA); PG8_STAGE(PG8_SB(0, 1), cB + hstep, voffB); PG8_STAGE(PG8_SA(0, 1), cA + hstep, voffA);
        if (wr == 1) PG8_BAR;
        PG8_WAIT_V(4); PG8_BAR;
        PG8_STAGE(PG8_SB(1, 0), cB + kstep, voffB); PG8_STAGE(PG8_SA(1, 0), cA + kstep, voffA); PG8_STAGE(PG8_SB(1, 1), cB + hstep + kstep, voffB);
        PG8_WAIT_V(6); PG8_BAR;
    }
    for (;;) {
        const bool has_next = S.next(ui + 1, nxt);
        const char* nA = has_next ? (const char*)g.A + (size_t)nxt.pm * tstep : cA; const char* nB = has_next ? (const char*)g.Bt + (size_t)nxt.pn * tstep : cB;
        for (int t = 0; t < nt; t += 2) {
            const bool last = (t == nt - 2);
            const char* a1 = cA + (size_t)(t + 1) * kstep;
            const char* a2 = last ? nA : cA + (size_t)(t + 2) * kstep; const char* b2 = last ? nB : cB + (size_t)(t + 2) * kstep;
            const char* a3 = a2 + kstep; const char* b3 = b2 + kstep;
            if (last && has_next) S.a_ready(nxt);
            if constexpr (SP2) {
            PG8_LDB(B0, 0, 0); PG8_LDB(B1, 0, 1); PG8_SCHED; PG8_LDA(At, 0, 0); PG8_STAGE(PG8_SA(1, 1), a1 + hstep, voffA);
            PG8_WAIT_V(8); PG8_WAIT_L(0); PG8_BAR; PG8_MMA(0, 0, At, B0); PG8_MMA(0, 1, At, B1); PG8_BAR; PG8_SCHED;
            PG8_LDA(At, 0, 1); PG8_STAGE(PG8_SB(0, 0), b2, voffB); PG8_STAGE(PG8_SB(0, 1), b2 + hstep, voffB); PG8_STAGE(PG8_SA(0, 0), a2, voffA);
            PG8_WAIT_V(8); PG8_WAIT_L(0); PG8_BAR; PG8_MMA(1, 0, At, B0); PG8_MMA(1, 1, At, B1); PG8_BAR; PG8_SCHED;
            PG8_LDB(B0, 1, 0); PG8_LDB(B1, 1, 1); PG8_SCHED; PG8_LDA(At, 1, 0); PG8_STAGE(PG8_SA(0, 1), a2 + hstep, voffA);
            PG8_WAIT_V(8); PG8_WAIT_L(0); PG8_BAR; PG8_MMA(0, 0, At, B0); PG8_MMA(0, 1, At, B1); PG8_BAR; PG8_SCHED;
            PG8_LDA(At, 1, 1); PG8_STAGE(PG8_SB(1, 0), b3, voffB); PG8_STAGE(PG8_SB(1, 1), b3 + hstep, voffB); PG8_STAGE(PG8_SA(1, 0), a3, voffA);
            PG8_WAIT_V(8); PG8_WAIT_L(0); PG8_BAR; PG8_MMA(1, 0, At, B0); PG8_MMA(1, 1, At, B1); PG8_BAR; PG8_SCHED;
            } else {
            PG8_LDB(B0, 0, 0); PG8_SCHED; PG8_LDA(At, 0, 0); PG8_STAGE(PG8_SA(1, 1), a1 + hstep, voffA);
            PG8_WAIT_L(8); PG8_BAR; PG8_WAIT_L(0); PG8_MMA(0, 0, At, B0); PG8_BAR; PG8_SCHED;
            PG8_LDB(B1, 0, 1); PG8_STAGE(PG8_SB(0, 0), b2, voffB);
            PG8_BAR; PG8_WAIT_L(0); PG8_MMA(0, 1, At, B1); PG8_BAR;
            PG8_LDA(At, 0, 1); PG8_STAGE(PG8_SA(0, 0), a2, voffA);
            PG8_BAR; PG8_WAIT_L(0); PG8_MMA(1, 0, At, B0); PG8_BAR; PG8_SCHED;
            PG8_STAGE(PG8_SB(0, 1), b2 + hstep, voffB);
            PG8_WAIT_V(6); PG8_BAR; PG8_MMA(1, 1, At, B1); PG8_BAR;
            PG8_LDB(B0, 1, 0); PG8_SCHED; PG8_LDA(At, 1, 0); PG8_STAGE(PG8_SA(0, 1), a2 + hstep, voffA);
            PG8_WAIT_L(8); PG8_BAR; PG8_WAIT_L(0); PG8_MMA(0, 0, At, B0); PG8_BAR; PG8_SCHED;
            PG8_LDB(B1, 1, 1); PG8_STAGE(PG8_SB(1, 0), b3, voffB);
            PG8_BAR; PG8_WAIT_L(0); PG8_MMA(0, 1, At, B1); PG8_BAR;
            PG8_LDA(At, 1, 1); PG8_STAGE(PG8_SA(1, 0), a3, voffA);
            PG8_BAR; PG8_WAIT_L(0); PG8_MMA(1, 0, At, B0); PG8_BAR; PG8_SCHED;
            PG8_STAGE(PG8_SB(1, 1), b3 + hstep, voffB);
            PG8_WAIT_V(6); PG8_BAR; PG8_MMA(1, 1, At, B1); PG8_BAR;
            }
        }
        if constexpr (ALIGN_EPI) { if (wr == 0) PG8_BAR; }
        if constexpr (!Epi::AFTER_DRAIN) { E(acc, cur, wr, wc, fr, fq); S.done(cur); }
        if (!has_next) break;
#pragma unroll
        for (int a = 0; a < 2; ++a)
#pragma unroll
            for (int b = 0; b < 2; ++b)
#pragma unroll
                for (int m = 0; m < 4; ++m)
#pragma unroll
                    for (int n = 0; n < 2; ++n) acc[a][b][m][n] = (f32x4){0.f, 0.f, 0.f, 0.f};
        cur = nxt; cA = nA; cB = nB; ++ui;
        if constexpr (ALIGN_EPI) { if (wr == 1) PG8_BAR; }
    }
    PG8_WAIT_V(0);
    if constexpr (!ALIGN_EPI) { if (wr == 0) PG8_BAR; }
    PG8_BAR;
#undef PG8_SA
#undef PG8_SB
#undef PG8_STAGE
#undef PG8_LDA
#undef PG8_LDB
#undef PG8_MMA
#undef PG8_WAIT_V
#undef PG8_WAIT_L
#undef PG8_BAR
#undef PG8_SCHED
}
}

constexpr int NWAVES = 8;
constexpr int D = 4096, NB = 4, SEQ = 4096, M = NB * SEQ, FF = 11008;
constexpr int NGLU = 2 * D, NUP = 2 * FF, NQKV = 5120;
constexpr int S5G = 256, S5P = 64, S5C = 16;
constexpr float EPS = 1e-6f;

constexpr size_t MiB = 1u << 20;
constexpr size_t WS_CTL = 0, CTL_ZERO_BYTES = 1 * MiB;
constexpr size_t WS_RS = 1 * MiB;
constexpr size_t WS_WGLU = 2 * MiB, WS_WUP0 = 66 * MiB, WS_WDN0 = 238 * MiB, WS_WQKV = 324 * MiB, WS_WO = 364 * MiB, WS_WUP1 = 396 * MiB, WS_WDN1 = 568 * MiB;
constexpr size_t WS_HB = 654 * MiB, WS_GA = 782 * MiB, WS_MB = 910 * MiB, WS_ACT = 1038 * MiB, WS_END = 1382 * MiB;
constexpr size_t WS_Q = WS_ACT, WS_K = WS_ACT + 128 * MiB, WS_V = WS_ACT + 144 * MiB;
constexpr int CW_BAR = 4096;

constexpr int RING_OFF = 0, RING_BYTES = 131072;
constexpr int LDSCTL_OFF = RING_BYTES, MISC_OFF = LDSCTL_OFF + 320;
constexpr int LDS_BYTES = 147456;

#define GAS __attribute__((address_space(1)))
#define LAS __attribute__((address_space(3)))
typedef unsigned short bf16;
typedef unsigned v4u __attribute__((ext_vector_type(4)));
typedef unsigned v2u __attribute__((ext_vector_type(2)));
typedef float f32x4 __attribute__((ext_vector_type(4)));
typedef float f32x16 __attribute__((ext_vector_type(16)));
typedef short bf16x8 __attribute__((ext_vector_type(8)));
using bf16x2 = __attribute__((ext_vector_type(2))) __bf16;
typedef GAS unsigned gu32;
#define LDS_WAIT() asm volatile("s_waitcnt lgkmcnt(0)" ::: "memory")
#define VM_WAIT() asm volatile("s_waitcnt vmcnt(0)" ::: "memory")
__device__ __forceinline__ unsigned pk2(float lo, float hi) { return pg8::cvt_pk_bf16(lo, hi); }
__device__ __forceinline__ float bf_lo(unsigned w) { return __uint_as_float(w << 16); }
__device__ __forceinline__ float bf_hi(unsigned w) { return __uint_as_float(w & 0xffff0000u); }

#define XB_TMO      128
#define XB_XCNT(j)  (256  + 64 * (j))
#define XB_XSUB(j)  (1280 + 64 * (j))
#define XB_XGEN(j)  (2304 + 64 * (j))
#define XB_TOP      3328
#define XB_TOPGEN   3392
#define XCD_BAR_WORDS 3456
#define XB_SPIN_CAP (1u << 18)

__device__ __forceinline__ unsigned xb_ld(unsigned* p)              { return __hip_atomic_load(p, __ATOMIC_RELAXED, __HIP_MEMORY_SCOPE_AGENT); }
__device__ __forceinline__ unsigned xb_add(unsigned* p, unsigned v) { return __hip_atomic_fetch_add(p, v, __ATOMIC_RELAXED, __HIP_MEMORY_SCOPE_AGENT); }
__device__ __forceinline__ unsigned xb_xcc_id() { return (unsigned)__builtin_amdgcn_s_getreg((3 << 11) | 20) & 0xFu; }
#define XB_SPIN(cond, bar) do { unsigned _sp = 0; while (cond) { __builtin_amdgcn_s_sleep(1); \
    if ((++_sp & 255u) == 0u) { if (xb_ld(&(bar)[XB_TMO])) break; if (_sp > XB_SPIN_CAP) { atomicAdd(&(bar)[XB_TMO], 1u); break; } } } } while (0)

struct XcdBarrier {
    unsigned* bar; unsigned x;
    volatile LAS unsigned* st;
};
__device__ __forceinline__ XcdBarrier xcd_barrier_post(unsigned* bar, volatile LAS unsigned* st) {
    XcdBarrier b; b.bar = bar; b.x = xb_xcc_id(); b.st = st;
    if (threadIdx.x == 0) (void)xb_add(&bar[XB_XCNT(b.x)], 1u);
    return b;
}
__device__ __forceinline__ void xcd_barrier_complete(unsigned* bar, unsigned x, unsigned& nloc, unsigned& nx) {
    const unsigned G = gridDim.x * gridDim.y * gridDim.z;
    unsigned sum, cnt, mine, sp = 0u;
    for (;;) {
        sum = 0u; cnt = 0u; mine = 0u;
#pragma unroll
        for (unsigned j = 0; j < 16; ++j) { const unsigned c = xb_ld(&bar[XB_XCNT(j)]); sum += c; cnt += (c > 0u) ? 1u : 0u; mine = (j == x) ? c : mine; }
        if (sum == G) break;
        __builtin_amdgcn_s_sleep(1);
        if ((++sp & 255u) == 0u) { if (xb_ld(&bar[XB_TMO])) break; if (sp > XB_SPIN_CAP) { atomicAdd(&bar[XB_TMO], 1u); break; } }
    }
    nloc = mine > 0u ? mine : 1u; nx = cnt > 0u ? cnt : 1u;
}
__device__ __forceinline__ void xcd_barrier(const XcdBarrier& b) {
    asm volatile("s_waitcnt vmcnt(0)" ::: "memory");
    __syncthreads();
    if (threadIdx.x == 0) {
        unsigned* bar = b.bar;
        __builtin_amdgcn_s_waitcnt(0);
        unsigned nloc = b.st[0], nx = b.st[1];
        if (nloc == 0u) { xcd_barrier_complete(bar, b.x, nloc, nx); b.st[0] = nloc; b.st[1] = nx; }
        const unsigned old = xb_add(&bar[XB_XSUB(b.x)], 1u);
        const unsigned gen = old / nloc;
        if (old + 1u == (gen + 1u) * nloc) {
            __builtin_amdgcn_fence(__ATOMIC_RELEASE, "agent");
            asm volatile("s_waitcnt vmcnt(0)" ::: "memory");
            const unsigned og = xb_add(&bar[XB_TOP], 1u);
            const unsigned tg = og / nx;
            if (og + 1u == (tg + 1u) * nx) xb_add(&bar[XB_TOPGEN], 1u);
            else XB_SPIN(xb_ld(&bar[XB_TOPGEN]) == tg, bar);
            __builtin_amdgcn_fence(__ATOMIC_ACQUIRE, "agent");
            xb_add(&bar[XB_XGEN(b.x)], 1u);
            asm volatile("s_waitcnt vmcnt(0)" ::: "memory");
        } else {
            XB_SPIN(xb_ld(&bar[XB_XGEN(b.x)]) == gen, bar);
            __builtin_amdgcn_fence(__ATOMIC_ACQUIRE, "agent");
            asm volatile("s_waitcnt vmcnt(0)" ::: "memory");
        }
    }
    __syncthreads();
}

struct Frame {
    LAS unsigned char* lds;
    int tid, lane, wave;
    int vcu, G;
};
__device__ __forceinline__ float wave_sum(float v) {
#pragma unroll
    for (int o = 1; o < 64; o <<= 1) v += __shfl_xor(v, o);
    return v;
}

__device__ __forceinline__ void p0_item(const float* __restrict__ W, int K, int N, bf16* __restrict__ WT, int drow0, const float* __restrict__ gain, LAS float* scr, int k0, int n0, int lane) {
#pragma unroll 8
    for (int i = 0; i < 32; ++i) { const int kk = 2 * i + (lane >> 5); scr[kk * 33 + (lane & 31)] = W[(size_t)(k0 + kk) * N + n0 + (lane & 31)]; }
    LDS_WAIT(); asm volatile("" ::: "memory");
    const int c = lane & 7;
    float gk[8];
#pragma unroll
    for (int e = 0; e < 8; ++e) gk[e] = gain ? gain[k0 + 8 * c + e] : 1.0f;
#pragma unroll
    for (int j = 0; j < 4; ++j) { const int n = (lane >> 3) + 8 * j; const LAS float* s = scr + (8 * c) * 33 + n;
        v4u o; o.x = pk2(s[0 * 33] * gk[0], s[1 * 33] * gk[1]); o.y = pk2(s[2 * 33] * gk[2], s[3 * 33] * gk[3]); o.z = pk2(s[4 * 33] * gk[4], s[5 * 33] * gk[5]); o.w = pk2(s[6 * 33] * gk[6], s[7 * 33] * gk[7]);
        *(GAS v4u*)(WT + (size_t)(drow0 + n) * K + k0 + 8 * c) = o; }
    LDS_WAIT(); asm volatile("" ::: "memory");
}
__device__ __forceinline__ int map_pair(int n0, int bj) { return 256 * (n0 >> 7) + 128 * bj + (n0 & 127); }
__device__ __forceinline__ int map_qkv(int n0) { const int head = n0 >> 6, bj = (n0 >> 5) & 1; return 256 * (head >> 2) + 128 * bj + 32 * (head & 3); }

struct Args { const void* in[26]; float* out; unsigned char* ws; };

__device__ __forceinline__ void p0_prologue(Frame& F, const Args& A) {
    LAS float* scr = (LAS float*)(F.lds + RING_OFF + F.wave * 16384);
    const int gw = F.vcu * NWAVES + F.wave, NGW = F.G * NWAVES;
    unsigned char* ws = A.ws;
    constexpr int I_SQ = (D / 64) * (D / 32);
    constexpr int I_UP = (D / 64) * (FF / 32);
    constexpr int I_DN = (FF / 64) * (D / 32);
    constexpr int I_QKV = (D / 64) * (NQKV / 32);
    constexpr int NITEMS = 2 * I_SQ + 2 * (2 * I_UP + I_DN) + I_QKV + I_SQ;
    const float* npm = (const float*)A.in[2];
    const float* npf = (const float*)A.in[4];
    for (int it = gw; it < NITEMS; it += NGW) {
        int r = it;
        if (r < 2 * I_SQ) { const int bj = r >= I_SQ; r -= bj * I_SQ; const int nblk = D / 32, kb = r / nblk, nb = r % nblk;
            p0_item((const float*)A.in[bj ? 16 : 14], D, D, (bf16*)(ws + WS_WGLU), map_pair(32 * nb, bj), nullptr, scr, 64 * kb, 32 * nb, F.lane); continue; }
        r -= 2 * I_SQ;
        bool done = false;
#pragma unroll
        for (int l = 0; l < 2; ++l) {
            if (done) break;
            if (r < 2 * I_UP) { const int bj = r >= I_UP; r -= bj * I_UP; const int nblk = FF / 32, kb = r / nblk, nb = r % nblk;
                p0_item((const float*)A.in[bj ? 24 : 23] + (size_t)l * D * FF, D, FF, (bf16*)(ws + (l ? WS_WUP1 : WS_WUP0)), map_pair(32 * nb, bj), npf + l * D, scr, 64 * kb, 32 * nb, F.lane); done = true; break; }
            r -= 2 * I_UP;
            if (r < I_DN) { const int nblk = D / 32, kb = r / nblk, nb = r % nblk;
                p0_item((const float*)A.in[25] + (size_t)l * FF * D, FF, D, (bf16*)(ws + (l ? WS_WDN1 : WS_WDN0)), 32 * nb, nullptr, scr, 64 * kb, 32 * nb, F.lane); done = true; break; }
            r -= I_DN;
        }
        if (done) continue;
        if (r < I_QKV) { const int nblk = NQKV / 32, kb = r / nblk, nb = r % nblk;
            p0_item((const float*)A.in[18], D, NQKV, (bf16*)(ws + WS_WQKV), map_qkv(32 * nb), npm + D, scr, 64 * kb, 32 * nb, F.lane); continue; }
        r -= I_QKV;
        { const int nblk = D / 32, kb = r / nblk, nb = r % nblk;
            p0_item((const float*)A.in[20], D, D, (bf16*)(ws + WS_WO), 32 * nb, nullptr, scr, 64 * kb, 32 * nb, F.lane); }
    }
    const float* x = (const float*)A.in[0]; float* rs0 = (float*)(ws + WS_RS);
    for (int m = gw; m < M; m += NGW) {
        const GAS f32x4* xr = (const GAS f32x4*)(x + (size_t)m * D) + F.lane; float s = 0.f;
#pragma unroll
        for (int j = 0; j < 16; ++j) { const f32x4 v = xr[64 * j]; s += (v.x * v.x + v.y * v.y) + (v.z * v.z + v.w * v.w); }
        s = wave_sum(s);
        if (F.lane == 0) rs0[m] = 1.0f / sqrtf(s * (1.0f / D) + EPS);
    }
}

__device__ __forceinline__ bf16x8 pack8(const f32x4 a, const f32x4 b) {
    v4u w; w.x = pk2(a.x, a.y); w.y = pk2(a.z, a.w); w.z = pk2(b.x, b.y); w.w = pk2(b.z, b.w); return __builtin_bit_cast(bf16x8, w);
}
__device__ __forceinline__ float gelu_tanh(float y) {
    const float z = 0.7978845608028654f * (y + 0.044715f * y * y * y);
    return y * __builtin_amdgcn_rcpf(1.0f + __builtin_amdgcn_exp2f(-2.0f * 1.4426950408889634f * z));
}
__device__ __forceinline__ void s5_phase(Frame& F, const Args& A) {
    const float* x = (const float*)A.in[0]; const float* rs0 = (const float*)(A.ws + WS_RS); const float* gain = (const float*)A.in[2];
    const float* lam_re = (const float*)A.in[6]; const float* lam_im = (const float*)A.in[7]; const float* log_step = (const float*)A.in[8];
    const float* b_re = (const float*)A.in[9]; const float* b_im = (const float*)A.in[10]; const float* c_re = (const float*)A.in[11]; const float* c_im = (const float*)A.in[12];
    const float* dsk = (const float*)A.in[13]; bf16* G = (bf16*)(A.ws + WS_GA);
    const int lane = F.lane;
    LAS unsigned char* wl = F.lds + RING_OFF + F.wave * 20480;
    LAS float* U = (LAS float*)wl;
    LAS unsigned char* Sim = wl + 10240;
    const int n = lane & 31, h = lane >> 5;
    const int cc = lane & 15, kq = lane >> 4;
    for (int item = F.vcu + F.G * F.wave; item < 2 * S5G; item += F.G * NWAVES) {
        const int g = item & (S5G - 1), bp = item >> 8;
        const float stp = expf(log_step[g]);
        float lr[2], li[2]; bf16x8 Bf[4];
#pragma unroll
        for (int q = 0; q < 2; ++q) { const int p = n + 32 * q;
            const float are = lam_re[g * S5P + p], aim = lam_im[g * S5P + p];
            const float e = expf(are * stp); float sn, cs; sincosf(aim * stp, &sn, &cs);
            lr[q] = e * cs; li[q] = e * sn;
            const float nr = lr[q] - 1.0f, ni = li[q], den = 1.0f / (are * are + aim * aim);
            const float cr = (nr * are + ni * aim) * den, ci = (ni * are - nr * aim) * den;
            const float* brp = b_re + ((size_t)(g * S5P + p) * S5C + 8 * h); const float* bip = b_im + ((size_t)(g * S5P + p) * S5C + 8 * h);
            const f32x4 br0 = *(const f32x4*)brp, br1 = *(const f32x4*)(brp + 4), bi0 = *(const f32x4*)bip, bi1 = *(const f32x4*)(bip + 4);
            Bf[2 * q] = pack8(cr * br0 - ci * bi0, cr * br1 - ci * bi1);
            Bf[2 * q + 1] = pack8(cr * bi0 + ci * br0, cr * bi1 + ci * br1); }
        bf16x8 Cf[4];
#pragma unroll
        for (int ks = 0; ks < 4; ++ks) { const size_t o = (size_t)(g * S5C + cc) * S5P + 16 * ks + 4 * kq;
            const f32x4 cr4 = *(const f32x4*)(c_re + o), ci4 = *(const f32x4*)(c_im + o);
            v4u w; w.x = pk2(cr4.x, -ci4.x); w.y = pk2(cr4.y, -ci4.y); w.z = pk2(cr4.z, -ci4.z); w.w = pk2(cr4.w, -ci4.w); Cf[ks] = __builtin_bit_cast(bf16x8, w); }
        const f32x4 d4 = *(const f32x4*)(dsk + g * S5C + 4 * kq);
        const f32x4 gq = *(const f32x4*)(gain + g * S5C + 4 * (lane & 3));
        float sr[2] = {0.f, 0.f}, si[2] = {0.f, 0.f};
        f32x4 xv[8]; float rv[8];
#define S5_ISSUE(L0) do { _Pragma("unroll") for (int i = 0; i < 8; ++i) { const int row = i * 16 + (lane >> 2); const int grow = (2 * bp + (row >> 6)) * SEQ + (L0) + (row & 63); \
            xv[i] = *(const f32x4*)(x + (size_t)grow * D + g * S5C + 4 * (lane & 3)); rv[i] = rs0[grow]; } } while (0)
        S5_ISSUE(0);
        for (int L0 = 0; L0 < SEQ; L0 += 64) {
#pragma unroll
            for (int i = 0; i < 8; ++i) { const int row = i * 16 + (lane >> 2); *(LAS f32x4*)(U + row * 20 + 4 * (lane & 3)) = xv[i] * rv[i] * gq; }
            if (L0 + 64 < SEQ) S5_ISSUE(L0 + 64);
#pragma unroll 1
            for (int st = 0; st < 4; ++st) {
                const LAS float* up = U + (((n >> 2) & 1) * 64 + 16 * st + (n & 3) + 4 * (n >> 3)) * 20 + 8 * h;
                const bf16x8 Af = pack8(*(const LAS f32x4*)up, *(const LAS f32x4*)(up + 4));
                f32x16 acc[4];
#pragma unroll
                for (int nb = 0; nb < 4; ++nb) { f32x16 z;
#pragma unroll
                    for (int r = 0; r < 16; ++r) z[r] = 0.f;
                    acc[nb] = __builtin_amdgcn_mfma_f32_32x32x16_bf16(Af, Bf[nb], z, 0, 0, 0); }
#pragma unroll
                for (int r = 0; r < 16; ++r)
#pragma unroll
                    for (int q = 0; q < 2; ++q) {
                        const float nr = fmaf(lr[q], sr[q], fmaf(-li[q], si[q], acc[2 * q][r]));
                        const float ni = fmaf(lr[q], si[q], fmaf(li[q], sr[q], acc[2 * q + 1][r]));
                        sr[q] = nr; si[q] = ni;
                        *(LAS unsigned*)(Sim + (16 * h + r) * 288 + 4 * (n + 32 * q)) = pk2(nr, ni);
                    }
#pragma unroll
                for (int hb = 0; hb < 2; ++hb) {
                    f32x4 y = {0.f, 0.f, 0.f, 0.f};
#pragma unroll
                    for (int ks = 0; ks < 4; ++ks) { const bf16x8 sb = *(const LAS bf16x8*)(Sim + (16 * hb + cc) * 288 + (32 * ks + 8 * kq) * 2);
                        y = __builtin_amdgcn_mfma_f32_16x16x32_bf16(Cf[ks], sb, y, 0, 0, 0); }
                    const f32x4 u4 = *(const LAS f32x4*)(U + (hb * 64 + 16 * st + cc) * 20 + 4 * kq);
                    const f32x4 v = y + d4 * u4;
                    v2u w; w.x = pk2(gelu_tanh(v.x), gelu_tanh(v.y)); w.y = pk2(gelu_tanh(v.z), gelu_tanh(v.w));
                    *(GAS v2u*)(G + (size_t)((2 * bp + hb) * SEQ + L0 + 16 * st + cc) * D + g * S5C + 4 * kq) = w;
                }
            }
        }
#undef S5_ISSUE
    }
}

template <bool LAST>
__device__ __forceinline__ void resid_phase(Frame& F, const bf16* __restrict__ mb, const float* hprev, float* hout, bf16* __restrict__ hb, float* __restrict__ rs_out, const float* __restrict__ gain) {
    const int gw = F.vcu * NWAVES + F.wave, NGW = F.G * NWAVES, lane = F.lane;
    f32x4 gv[8][2];
#pragma unroll
    for (int j = 0; j < 8; ++j) { gv[j][0] = *(const f32x4*)(gain + j * 512 + lane * 8); gv[j][1] = *(const f32x4*)(gain + j * 512 + lane * 8 + 4); }
    for (int m = gw; m < M; m += NGW) {
        v4u mv[8]; f32x4 hv[8][2];
#pragma unroll
        for (int j = 0; j < 8; ++j) { mv[j] = *(const GAS v4u*)(mb + (size_t)m * D + j * 512 + lane * 8);
            hv[j][0] = *(const GAS f32x4*)(hprev + (size_t)m * D + j * 512 + lane * 8); hv[j][1] = *(const GAS f32x4*)(hprev + (size_t)m * D + j * 512 + lane * 8 + 4); }
        float s = 0.f;
#pragma unroll
        for (int j = 0; j < 8; ++j) { const float a0 = bf_lo(mv[j].x), a1 = bf_hi(mv[j].x), a2 = bf_lo(mv[j].y), a3 = bf_hi(mv[j].y), a4 = bf_lo(mv[j].z), a5 = bf_hi(mv[j].z), a6 = bf_lo(mv[j].w), a7 = bf_hi(mv[j].w);
            s += (a0 * a0 + a1 * a1) + (a2 * a2 + a3 * a3) + (a4 * a4 + a5 * a5) + (a6 * a6 + a7 * a7); }
        s = wave_sum(s);
        const float rm = 1.0f / sqrtf(s * (1.0f / D) + EPS);
        float s2 = 0.f;
#pragma unroll
        for (int j = 0; j < 8; ++j) {
            const f32x4 m0 = {bf_lo(mv[j].x), bf_hi(mv[j].x), bf_lo(mv[j].y), bf_hi(mv[j].y)}, m1 = {bf_lo(mv[j].z), bf_hi(mv[j].z), bf_lo(mv[j].w), bf_hi(mv[j].w)};
            const f32x4 h0 = hv[j][0] + m0 * rm * gv[j][0], h1 = hv[j][1] + m1 * rm * gv[j][1];
            s2 += (h0.x * h0.x + h0.y * h0.y) + (h0.z * h0.z + h0.w * h0.w) + (h1.x * h1.x + h1.y * h1.y) + (h1.z * h1.z + h1.w * h1.w);
            *(GAS f32x4*)(hout + (size_t)m * D + j * 512 + lane * 8) = h0; *(GAS f32x4*)(hout + (size_t)m * D + j * 512 + lane * 8 + 4) = h1;
            if (!LAST) { v4u o; o.x = pk2(h0.x, h0.y); o.y = pk2(h0.z, h0.w); o.z = pk2(h1.x, h1.y); o.w = pk2(h1.z, h1.w);
                *(GAS v4u*)(hb + (size_t)m * D + j * 512 + lane * 8) = o; }
        }
        if (!LAST) { s2 = wave_sum(s2); if (lane == 0) rs_out[m] = 1.0f / sqrtf(s2 * (1.0f / D) + EPS); }
    }
}

constexpr int ATT_KROW = 144, ATT_VROW = 272;
constexpr int ATT_KOFF = 0, ATT_VOFF = 256 * ATT_KROW;
__device__ __forceinline__ float dot2bf(unsigned a, unsigned b, float c) { return __builtin_amdgcn_fdot2_f32_bf16(__builtin_bit_cast(bf16x2, a), __builtin_bit_cast(bf16x2, b), c, false); }
__device__ __forceinline__ void attn_phase(Frame& F, const Args& A) {
    const bf16* Q = (const bf16*)(A.ws + WS_Q); const bf16* Kg = (const bf16*)(A.ws + WS_K); const bf16* Vg = (const bf16*)(A.ws + WS_V); bf16* O = (bf16*)(A.ws + WS_GA);
    const float* sinks = (const float*)A.in[22];
    LAS unsigned char* Ks = F.lds + RING_OFF + ATT_KOFF; LAS unsigned char* Vs = F.lds + RING_OFF + ATT_VOFF;
    const int tid = F.tid;
    for (int unit = F.vcu; unit < NB * 8 * 32; unit += F.G) {
        const int b = unit >> 8, kvh = (unit >> 5) & 7, qblk = unit & 31;
        const int key0 = 128 * (qblk - 1);
        __syncthreads();
#pragma unroll
        for (int i = 0; i < 4; ++i) { const int t = tid + 512 * i, kr = t >> 3, c = t & 7; const int ks = key0 + kr;
            v4u v = {0u, 0u, 0u, 0u}; if (ks >= 0) v = *(const GAS v4u*)(Kg + (size_t)(b * SEQ + ks) * 512 + kvh * 64 + 8 * c);
            *(LAS v4u*)(Ks + kr * ATT_KROW + 16 * c) = v; }
#pragma unroll
        for (int i = 0; i < 2; ++i) { const int t = tid + 512 * i, kp = t >> 3, c = t & 7; const int ks = key0 + 2 * kp;
            v4u va = {0u, 0u, 0u, 0u}, vb = {0u, 0u, 0u, 0u};
            if (ks >= 0) { va = *(const GAS v4u*)(Vg + (size_t)(b * SEQ + ks) * 512 + kvh * 64 + 8 * c); vb = *(const GAS v4u*)(Vg + (size_t)(b * SEQ + ks + 1) * 512 + kvh * 64 + 8 * c); }
            v4u w0, w1;
            w0.x = (va.x & 0xffffu) | (vb.x << 16); w0.y = (va.x >> 16) | (vb.x & 0xffff0000u); w0.z = (va.y & 0xffffu) | (vb.y << 16); w0.w = (va.y >> 16) | (vb.y & 0xffff0000u);
            w1.x = (va.z & 0xffffu) | (vb.z << 16); w1.y = (va.z >> 16) | (vb.z & 0xffff0000u); w1.z = (va.w & 0xffffu) | (vb.w << 16); w1.w = (va.w >> 16) | (vb.w & 0xffff0000u);
            *(LAS v4u*)(Vs + kp * ATT_VROW + 32 * c) = w0; *(LAS v4u*)(Vs + kp * ATT_VROW + 32 * c + 16) = w1; }
        __syncthreads();
        const int qi = tid & 127, hp = tid >> 7;
        const size_t qrow = (size_t)(b * SEQ + 128 * qblk + qi);
#pragma unroll 1
        for (int hh = 0; hh < 2; ++hh) {
            const int head = kvh * 8 + 2 * hp + hh;
            unsigned qw[32];
#pragma unroll
            for (int c = 0; c < 8; ++c) { const v4u v = *(const GAS v4u*)(Q + qrow * D + head * 64 + 8 * c); qw[4 * c] = v.x; qw[4 * c + 1] = v.y; qw[4 * c + 2] = v.z; qw[4 * c + 3] = v.w; }
            float o[64];
#pragma unroll
            for (int d = 0; d < 64; ++d) o[d] = 0.f;
            float mx = sinks[head], l = 1.0f;
            const int kp0 = (qi + 1) >> 1;
#pragma unroll 1
            for (int it = 0; it < 65; ++it) {
                const int kp = kp0 + it; const int kpc = kp < 127 ? kp : 127;
                const int ka = 2 * kp, kb = 2 * kp + 1;
                const bool va = (ka >= qi + 1) && (ka <= qi + 128) && (key0 + ka >= 0), vb = (kb >= qi + 1) && (kb <= qi + 128) && (key0 + kb >= 0);
                float sa = 0.f, sb = 0.f;
                const LAS unsigned char* kra = Ks + (2 * kpc) * ATT_KROW; const LAS unsigned char* krb = kra + ATT_KROW;
#pragma unroll
                for (int c = 0; c < 8; ++c) { const v4u x = *(const LAS v4u*)(kra + 16 * c), y = *(const LAS v4u*)(krb + 16 * c);
                    sa = dot2bf(x.x, qw[4 * c], sa); sa = dot2bf(x.y, qw[4 * c + 1], sa); sa = dot2bf(x.z, qw[4 * c + 2], sa); sa = dot2bf(x.w, qw[4 * c + 3], sa);
                    sb = dot2bf(y.x, qw[4 * c], sb); sb = dot2bf(y.y, qw[4 * c + 1], sb); sb = dot2bf(y.z, qw[4 * c + 2], sb); sb = dot2bf(y.w, qw[4 * c + 3], sb); }
                sa = va ? sa * 0.125f : -1e30f; sb = vb ? sb * 0.125f : -1e30f;
                const float gm = fmaxf(sa, sb);
                if (gm > mx) { const float al = __expf(mx - gm); l *= al;
#pragma unroll
                    for (int d = 0; d < 64; ++d) o[d] *= al;
                    mx = gm; }
                const float pa = va ? __expf(sa - mx) : 0.f, pb = vb ? __expf(sb - mx) : 0.f;
                l += pa + pb;
                const unsigned pp = pk2(pa, pb);
                const LAS unsigned char* vr = Vs + kpc * ATT_VROW;
#pragma unroll
                for (int c = 0; c < 16; ++c) { const v4u v = *(const LAS v4u*)(vr + 16 * c);
                    o[4 * c] = dot2bf(pp, v.x, o[4 * c]); o[4 * c + 1] = dot2bf(pp, v.y, o[4 * c + 1]); o[4 * c + 2] = dot2bf(pp, v.z, o[4 * c + 2]); o[4 * c + 3] = dot2bf(pp, v.w, o[4 * c + 3]); }
            }
            const float inv = 1.0f / l;
#pragma unroll
            for (int c = 0; c < 8; ++c) { v4u w; w.x = pk2(o[8 * c] * inv, o[8 * c + 1] * inv); w.y = pk2(o[8 * c + 2] * inv, o[8 * c + 3] * inv); w.z = pk2(o[8 * c + 4] * inv, o[8 * c + 5] * inv); w.w = pk2(o[8 * c + 6] * inv, o[8 * c + 7] * inv);
                *(GAS v4u*)(O + qrow * D + head * 64 + 8 * c) = w; }
        }
    }
    __syncthreads();
}

__global__ void __launch_bounds__(NWAVES * 64, 2) fwd(Args args) {
    extern __shared__ __attribute__((aligned(16))) unsigned char lds[];
    Frame F;
    F.lds = (LAS unsigned char*)lds;
    F.tid = threadIdx.x; F.lane = F.tid & 63; F.wave = __builtin_amdgcn_readfirstlane(F.tid >> 6);
    F.G = gridDim.x; { const int bx = blockIdx.x; F.vcu = (F.G % 8 == 0) ? (bx % 8) * (F.G / 8) + bx / 8 : bx; }
    unsigned char* ws = args.ws;
    for (int u = F.tid; u < (LDS_BYTES - LDSCTL_OFF) / 4; u += NWAVES * 64) ((LAS unsigned*)(F.lds + LDSCTL_OFF))[u] = 0u;
    __syncthreads();
    XcdBarrier bar = xcd_barrier_post((unsigned*)(ws + WS_CTL) + CW_BAR, (volatile LAS unsigned*)(F.lds + MISC_OFF) + 8);
    float* rs = (float*)(ws + WS_RS);
    const float* x = (const float*)args.in[0];
    bf16* HB = (bf16*)(ws + WS_HB); bf16* GA = (bf16*)(ws + WS_GA); bf16* MB = (bf16*)(ws + WS_MB); bf16* ACT = (bf16*)(ws + WS_ACT);
    const float* n_post_mix = (const float*)args.in[3]; const float* n_post_ffn = (const float*)args.in[5];

    p0_prologue(F, args); xcd_barrier(bar);
    s5_phase(F, args); xcd_barrier(bar);
    { pg8::Gemm g{GA, (const bf16*)(ws + WS_WGLU), M, NGLU, D}; pg8::StaticOrder S; S.init(M, NGLU, F.G, (int)blockIdx.x);
      pg8::EpiGlu E{MB, D, (const float*)args.in[15], (const float*)args.in[17]};
      pg8::gemm_phase<pg8::EpiGlu, pg8::StaticOrder, true, true>(F.lds + RING_OFF, g, S, E); }
    xcd_barrier(bar);
    resid_phase<false>(F, MB, x, args.out, HB, rs + M, n_post_mix); xcd_barrier(bar);

#define FFN_PHASES(layer) do { \
        { pg8::Gemm g{HB, (const bf16*)(ws + (layer ? WS_WUP1 : WS_WUP0)), M, NUP, D}; pg8::StaticOrder S; S.init(M, NUP, F.G, (int)blockIdx.x); \
          pg8::EpiSwiglu E{ACT, FF, rs + (layer ? 3 : 1) * M}; \
          pg8::gemm_phase<pg8::EpiSwiglu, pg8::StaticOrder, true, true>(F.lds + RING_OFF, g, S, E); } \
        xcd_barrier(bar); \
        { pg8::Gemm g{ACT, (const bf16*)(ws + (layer ? WS_WDN1 : WS_WDN0)), M, D, FF}; pg8::StaticOrder S; S.init(M, D, F.G, (int)blockIdx.x); \
          pg8::EpiPlain E{MB, D, nullptr}; \
          pg8::gemm_phase<pg8::EpiPlain, pg8::StaticOrder, true, true>(F.lds + RING_OFF, g, S, E); } \
        xcd_barrier(bar); } while (0)
    FFN_PHASES(0);
    resid_phase<false>(F, MB, args.out, args.out, HB, rs + 2 * M, n_post_ffn); xcd_barrier(bar);
            { pg8::Gemm g{HB, (const bf16*)(ws + WS_WQKV), M, NQKV, D}; pg8::StaticOrder S; S.init(M, NQKV, F.G, (int)blockIdx.x);
              pg8::EpiQkv E{(bf16*)(ws + WS_Q), (bf16*)(ws + WS_K), (bf16*)(ws + WS_V), rs + 2 * M, (const float*)args.in[19], (const int*)args.in[1]};
              pg8::gemm_phase<pg8::EpiQkv, pg8::StaticOrder, true, true>(F.lds + RING_OFF, g, S, E); }
            xcd_barrier(bar);
            attn_phase(F, args); xcd_barrier(bar);
            { pg8::Gemm g{GA, (const bf16*)(ws + WS_WO), M, D, D}; pg8::StaticOrder S; S.init(M, D, F.G, (int)blockIdx.x);
              pg8::EpiPlain E{MB, D, (const float*)args.in[21]};
              pg8::gemm_phase<pg8::EpiPlain, pg8::StaticOrder, true, true>(F.lds + RING_OFF, g, S, E); }
            xcd_barrier(bar);
            resid_phase<false>(F, MB, args.out, args.out, HB, rs + 3 * M, n_post_mix + D); xcd_barrier(bar);
    FFN_PHASES(1);
    resid_phase<true>(F, MB, args.out, args.out, HB, rs, n_post_ffn + D);
}
extern "C" void kernel_launch(void* const* d_in, const int* in_sizes, int n_in, void* d_out, int out_size, void* d_ws, size_t ws_size, hipStream_t stream) {
    static int grid = 0;
    if (grid == 0) {
        if (n_in != 26 || in_sizes[0] != M * D || out_size != M * D || ws_size < WS_END) { fprintf(stderr, "kernel_launch: unexpected shapes (n_in %d, in0 %d, out %d, ws %zu); nothing launched\n", n_in, n_in > 0 ? in_sizes[0] : -1, out_size, ws_size); grid = -1; return; }
        int dev = 0, cus = 0, per_cu = 0;
        if (hipGetDevice(&dev) != hipSuccess || hipDeviceGetAttribute(&cus, hipDeviceAttributeMultiprocessorCount, dev) != hipSuccess) { grid = -1; return; }
        if (hipFuncSetAttribute((const void*)fwd, hipFuncAttributeMaxDynamicSharedMemorySize, LDS_BYTES) != hipSuccess) { fprintf(stderr, "kernel_launch: hipFuncSetAttribute failed\n"); grid = -1; return; }
        if (hipOccupancyMaxActiveBlocksPerMultiprocessor(&per_cu, (const void*)fwd, NWAVES * 64, LDS_BYTES) != hipSuccess || per_cu < 1)
            fprintf(stderr, "kernel_launch: note: occupancy query reports %d workgroups per CU\n", per_cu);
        (void)hipGetLastError();
        grid = cus;
    }
    if (grid < 0) return;
    if (hipMemsetAsync((char*)d_ws + WS_CTL, 0, CTL_ZERO_BYTES, stream) != hipSuccess) { fprintf(stderr, "kernel_launch: hipMemsetAsync failed\n"); return; }
    Args a{};
    for (int i = 0; i < 26; ++i) a.in[i] = d_in[i];
    a.out = (float*)d_out; a.ws = (unsigned char*)d_ws;
    hipLaunchKernelGGL(fwd, dim3(grid), dim3(NWAVES * 64), LDS_BYTES, stream, a);
    const hipError_t le = hipPeekAtLastError();
    if (le != hipSuccess) fprintf(stderr, "kernel_launch: launch failed: %s\n", hipGetErrorName(le));
}
```

```cpp
#include <hip/hip_runtime.h>
#include <cstdio>
#include <cstdint>

namespace pg8 {
#define PG8_LAS __attribute__((address_space(3)))
typedef unsigned short bf16_t;
typedef short bf16x8 __attribute__((ext_vector_type(8)));
typedef float f32x4 __attribute__((ext_vector_type(4)));
typedef unsigned u32x4 __attribute__((ext_vector_type(4)));
constexpr int BM = 256, BK = 64, HALF = 128, HTB = HALF * BK * 2, STAGE_BYTES = 8 * HTB, NXCD = 8, WGM = 8;

__host__ __device__ __forceinline__ int lds_byte(int r, int c) { const int st = (r >> 4) * 2 + (c >> 5), rr = r & 15, cc = c & 31, ob = rr * 64 + cc * 2; return st * 1024 + (ob ^ (((ob >> 9) & 1) << 5)); }
__host__ __device__ __forceinline__ void stage_rc(int b, int& R, int& C) { const int st = b / 1024, sb = b % 1024, swz = sb ^ (((sb >> 9) & 1) << 5); R = (st >> 1) * 16 + swz / 64; C = (st & 1) * 32 + (swz % 64) / 2; }
__host__ __device__ __forceinline__ int perm32(int rho) { const int n = rho >> 4, i = rho & 15; return 8 * (i >> 2) + 4 * n + (i & 3); }

struct Unit { int pm, pn; };
struct Gemm { const bf16_t* A; const bf16_t* Bt; int M, N, K; };

struct StaticOrder {
    int nM, nN, nwg, G, c;
    __host__ __device__ void init(int M, int N, int G_, int c_) { nM = M / BM; nN = N / BM; nwg = nM * nN; G = G_; c = c_; }
    __host__ __device__ bool next(int i, Unit& u) const {
        const long L = (long)i * G + c; if (L >= nwg) return false;
        int wgid = (int)L; { const int q = nwg / NXCD, r = nwg % NXCD, xcd = wgid % NXCD, off = wgid / NXCD; wgid = (xcd < r ? xcd * (q + 1) : r * (q + 1) + (xcd - r) * q) + off; }
        const int nig = WGM * nN, gid = wgid / nig, fm = gid * WGM, gsz = (nM - fm) < WGM ? (nM - fm) : WGM;
        u.pm = fm + ((wgid % nig) % gsz); u.pn = (wgid % nig) / gsz; return true;
    }
    __device__ __forceinline__ void a_ready(const Unit&) const {}
    __device__ __forceinline__ void done(const Unit&) const {}
};

__device__ __forceinline__ unsigned cvt_pk_bf16(float lo, float hi) { unsigned r; asm volatile("v_cvt_pk_bf16_f32 %0, %1, %2" : "=v"(r) : "v"(lo), "v"(hi)); return r; }


struct EpiPlain {
    static constexpr bool PERM = true, AFTER_DRAIN = false;
    bf16_t* O; int ldc; const float* bias;
    __device__ __forceinline__ void operator()(const f32x4 (&acc)[2][2][4][2], const Unit& u, int wr, int wc, int fr, int fq) const {
        const int row0 = u.pm * BM + wr * 64 + fr; const int col0 = u.pn * BM + wc * 32 + 8 * fq;
        f32x4 bv[2][2];
#pragma unroll
        for (int bj = 0; bj < 2; ++bj)
#pragma unroll
            for (int n = 0; n < 2; ++n) bv[bj][n] = bias ? *(const f32x4*)(bias + col0 + bj * HALF + 4 * n) : (f32x4){0.f, 0.f, 0.f, 0.f};
#pragma unroll
        for (int ai = 0; ai < 2; ++ai)
#pragma unroll
            for (int m = 0; m < 4; ++m) { bf16_t* rowp = O + (size_t)(row0 + ai * HALF + m * 16) * ldc + col0;
#pragma unroll
                for (int bj = 0; bj < 2; ++bj) { const f32x4 v0 = acc[ai][bj][m][0] + bv[bj][0], v1 = acc[ai][bj][m][1] + bv[bj][1];
                    u32x4 w; w.x = cvt_pk_bf16(v0[0], v0[1]); w.y = cvt_pk_bf16(v0[2], v0[3]); w.z = cvt_pk_bf16(v1[0], v1[1]); w.w = cvt_pk_bf16(v1[2], v1[3]);
                    *(u32x4*)(rowp + bj * HALF) = w; } }
    }
};
__device__ __forceinline__ float sigmoid_f(float x) { return __builtin_amdgcn_rcpf(1.0f + __builtin_amdgcn_exp2f(-1.4426950408889634f * x)); }
struct EpiGlu {
    static constexpr bool PERM = true, AFTER_DRAIN = false;
    bf16_t* O; int ldc; const float* b1; const float* b2;
    __device__ __forceinline__ void operator()(const f32x4 (&acc)[2][2][4][2], const Unit& u, int wr, int wc, int fr, int fq) const {
        const int row0 = u.pm * BM + wr * 64 + fr; const int col0 = u.pn * HALF + wc * 32 + 8 * fq;
        f32x4 bv[2][2];
#pragma unroll
        for (int n = 0; n < 2; ++n) { bv[0][n] = *(const f32x4*)(b1 + col0 + 4 * n); bv[1][n] = *(const f32x4*)(b2 + col0 + 4 * n); }
#pragma unroll
        for (int ai = 0; ai < 2; ++ai)
#pragma unroll
            for (int m = 0; m < 4; ++m) { bf16_t* rowp = O + (size_t)(row0 + ai * HALF + m * 16) * ldc + col0;
                f32x4 o[2];
#pragma unroll
                for (int n = 0; n < 2; ++n) { const f32x4 a = acc[ai][0][m][n] + bv[0][n], g = acc[ai][1][m][n] + bv[1][n];
#pragma unroll
                    for (int j = 0; j < 4; ++j) o[n][j] = a[j] * sigmoid_f(g[j]); }
                u32x4 w; w.x = cvt_pk_bf16(o[0][0], o[0][1]); w.y = cvt_pk_bf16(o[0][2], o[0][3]); w.z = cvt_pk_bf16(o[1][0], o[1][1]); w.w = cvt_pk_bf16(o[1][2], o[1][3]);
                *(u32x4*)rowp = w; }
    }
};
struct EpiSwiglu {
    static constexpr bool PERM = true, AFTER_DRAIN = false;
    bf16_t* O; int ldc; const float* rstd;
    __device__ __forceinline__ void operator()(const f32x4 (&acc)[2][2][4][2], const Unit& u, int wr, int wc, int fr, int fq) const {
        const int row0 = u.pm * BM + wr * 64 + fr; const int col0 = u.pn * HALF + wc * 32 + 8 * fq;
#pragma unroll
        for (int ai = 0; ai < 2; ++ai)
#pragma unroll
            for (int m = 0; m < 4; ++m) { const int row = row0 + ai * HALF + m * 16; const float rs = rstd[row]; bf16_t* rowp = O + (size_t)row * ldc + col0;
                f32x4 o[2];
#pragma unroll
                for (int n = 0; n < 2; ++n) { const f32x4 g = acc[ai][0][m][n] * rs, up = acc[ai][1][m][n] * rs;
#pragma unroll
                    for (int j = 0; j < 4; ++j) o[n][j] = g[j] * sigmoid_f(g[j]) * up[j]; }
                u32x4 w; w.x = cvt_pk_bf16(o[0][0], o[0][1]); w.y = cvt_pk_bf16(o[0][2], o[0][3]); w.z = cvt_pk_bf16(o[1][0], o[1][1]); w.w = cvt_pk_bf16(o[1][2], o[1][3]);
                *(u32x4*)rowp = w; }
    }
};
struct EpiQkv {
    static constexpr bool PERM = true, AFTER_DRAIN = false;
    bf16_t* Q; bf16_t* Kb; bf16_t* Vb; const float* rstd; const float* bias; const int* pos;
    __device__ __forceinline__ void operator()(const f32x4 (&acc)[2][2][4][2], const Unit& u, int wr, int wc, int fr, int fq) const {
        const int row0 = u.pm * BM + wr * 64 + fr; const int head = 4 * u.pn + wc;
        bf16_t* base; int ld, hcol;
        if (head < 64) { base = Q; ld = 4096; hcol = head * 64; } else if (head < 72) { base = Kb; ld = 512; hcol = (head - 64) * 64; } else { base = Vb; ld = 512; hcol = (head - 72) * 64; }
        const bool rope = head < 72;
        f32x4 bv[2][2];
#pragma unroll
        for (int bj = 0; bj < 2; ++bj)
#pragma unroll
            for (int n = 0; n < 2; ++n) bv[bj][n] = *(const f32x4*)(bias + head * 64 + 32 * bj + 8 * fq + 4 * n);
        float invf[2][4];
#pragma unroll
        for (int n = 0; n < 2; ++n)
#pragma unroll
            for (int j = 0; j < 4; ++j) invf[n][j] = exp2f(-(float)(8 * fq + 4 * n + j) * (13.287712379549449f / 32.0f));
#pragma unroll
        for (int ai = 0; ai < 2; ++ai)
#pragma unroll
            for (int m = 0; m < 4; ++m) { const int row = row0 + ai * HALF + m * 16; const float rs = rstd[row]; const float p = (float)pos[row];
                f32x4 v[2][2];
#pragma unroll
                for (int bj = 0; bj < 2; ++bj)
#pragma unroll
                    for (int n = 0; n < 2; ++n) v[bj][n] = acc[ai][bj][m][n] * rs + bv[bj][n];
                if (rope) {
#pragma unroll
                    for (int n = 0; n < 2; ++n)
#pragma unroll
                        for (int j = 0; j < 4; ++j) { const float ang = p * invf[n][j]; const float t = __builtin_amdgcn_fractf(ang * 0.15915494309189535f);
                            const float sn = __builtin_amdgcn_sinf(t), cs = __builtin_amdgcn_cosf(t); const float x1 = v[0][n][j], x2 = v[1][n][j];
                            v[0][n][j] = x1 * cs - x2 * sn; v[1][n][j] = x2 * cs + x1 * sn; }
                }
                bf16_t* rowp = base + (size_t)row * ld + hcol + 8 * fq;
#pragma unroll
                for (int bj = 0; bj < 2; ++bj) { u32x4 w; w.x = cvt_pk_bf16(v[bj][0][0], v[bj][0][1]); w.y = cvt_pk_bf16(v[bj][0][2], v[bj][0][3]); w.z = cvt_pk_bf16(v[bj][1][0], v[bj][1][1]); w.w = cvt_pk_bf16(v[bj][1][2], v[bj][1][3]);
                    *(u32x4*)(rowp + 32 * bj) = w; } }
    }
};

template <class Epi, class Sched, bool ALIGN_EPI = false, bool SP2 = false>
__device__ __forceinline__ void gemm_phase(PG8_LAS unsigned char* lds, const Gemm g, const Sched& S, const Epi& E) {
    const int tid = threadIdx.x, wid = __builtin_amdgcn_readfirstlane(tid >> 6), lane = tid & 63, wr = wid >> 2, wc = wid & 3, fr = lane & 15, fq = lane >> 4;
    const int K = g.K, nt = K / BK;
    unsigned voffA[2], voffB[2];
#pragma unroll
    for (int i = 0; i < 2; ++i) { int R, C; stage_rc(tid * 16 + i * 8192, R, C); const int Rb = Epi::PERM ? ((R & ~31) + perm32(R & 31)) : R;
        voffA[i] = (unsigned)(R * K + C) * 2u; voffB[i] = (unsigned)(Rb * K + C) * 2u; }
    const size_t kstep = (size_t)(BK * 2);
    const size_t hstep = (size_t)HALF * K * 2;
    const size_t tstep = 2 * hstep;
    const unsigned ldsw = (unsigned)wid * 1024u;
    const int aoff = lds_byte(wr * 64 + fr, fq * 8), boff = lds_byte(wc * 32 + fr, fq * 8);
#define PG8_SA(b, h) (((b) * 2 + (h)) * HTB)
#define PG8_SB(b, h) ((4 + (b) * 2 + (h)) * HTB)
#define PG8_STAGE(bufoff, gbase, voff) do { _Pragma("unroll") for (int _i = 0; _i < 2; ++_i) \
        __builtin_amdgcn_global_load_lds((const unsigned*)((const char*)(gbase) + (voff)[_i]), (PG8_LAS unsigned*)(lds + (bufoff) + ldsw + _i * 8192), 16, 0, 0); } while (0)
#define PG8_LDA(dst, b, h) do { _Pragma("unroll") for (int m = 0; m < 4; ++m) _Pragma("unroll") for (int k = 0; k < 2; ++k) dst[m][k] = *(const PG8_LAS bf16x8*)(lds + PG8_SA(b, h) + aoff + m * 2048 + k * 1024); } while (0)
#define PG8_LDB(dst, b, h) do { _Pragma("unroll") for (int n = 0; n < 2; ++n) _Pragma("unroll") for (int k = 0; k < 2; ++k) dst[n][k] = *(const PG8_LAS bf16x8*)(lds + PG8_SB(b, h) + boff + n * 2048 + k * 1024); } while (0)
#define PG8_MMA(ai, bj, At, Bt) do { __builtin_amdgcn_s_setprio(1); _Pragma("unroll") for (int m = 0; m < 4; ++m) _Pragma("unroll") for (int n = 0; n < 2; ++n) _Pragma("unroll") for (int k = 0; k < 2; ++k) \
        acc[ai][bj][m][n] = __builtin_amdgcn_mfma_f32_16x16x32_bf16(Bt[n][k], At[m][k], acc[ai][bj][m][n], 0, 0, 0); __builtin_amdgcn_s_setprio(0); } while (0)
#define PG8_WAIT_V(n) asm volatile("s_waitcnt vmcnt(" #n ")" ::: "memory")
#define PG8_WAIT_L(n) asm volatile("s_waitcnt lgkmcnt(" #n ")" ::: "memory")
#define PG8_BAR __builtin_amdgcn_s_barrier()
#define PG8_SCHED __builtin_amdgcn_sched_barrier(0)
    Unit cur, nxt; int ui = 0;
    if (!S.next(0, cur)) return;
    f32x4 acc[2][2][4][2];
#pragma unroll
    for (int a = 0; a < 2; ++a)
#pragma unroll
        for (int b = 0; b < 2; ++b)
#pragma unroll
            for (int m = 0; m < 4; ++m)
#pragma unroll
                for (int n = 0; n < 2; ++n) acc[a][b][m][n] = (f32x4){0.f, 0.f, 0.f, 0.f};
    bf16x8 At[4][2], B0[2][2], B1[2][2];
    const char* cA = (const char*)g.A + (size_t)cur.pm * tstep; const char* cB = (const char*)g.Bt + (size_t)cur.pn * tstep;
    S.a_ready(cur);
    if constexpr (SP2) {
        PG8_STAGE(PG8_SB(0, 0), cB, voffB); PG8_STAGE(PG8_SB(0, 1), cB + hstep, voffB); PG8_STAGE(PG8_SA(0, 0), cA, voffA); PG8_STAGE(PG8_SA(0, 1), cA + hstep, voffA);
        if (wr == 1) PG8_BAR;
        PG8_WAIT_V(2); PG8_BAR;
        PG8_STAGE(PG8_SB(1, 0), cB + kstep, voffB); PG8_STAGE(PG8_SA(1, 0), cA + kstep, voffA); PG8_STAGE(PG8_SB(1, 1), cB + hstep + kstep, voffB);
        PG8_WAIT_V(6); PG8_BAR;
    } else {
        PG8_STAGE(PG8_SB(0, 0), cB, voffB); PG8_STAGE(PG8_SA(0, 0), cA, voffA); PG8_STAGE(PG8_SB(0, 1), cB + hstep, voffB); PG8_STAGE(PG8_SA(0, 1), cA + hstep, voffA);
        if (wr == 1) PG8_BAR;
        PG8_WAIT_V(4); PG8_BAR;
        PG8_STAGE(PG8_SB(1, 0), cB + kstep, voffB); PG8_STAGE(PG8_SA(1, 0), cA + kstep, voffA); PG8_STAGE(PG8_SB(1, 1), cB + hstep + kstep, voffB);
        PG8_WAIT_V(6); PG8_BAR;
    }
    for (;;) {
        const bool has_next = S.next(ui + 1, nxt);
        const char* nA = has_next ? (const char*)g.A + (size_t)nxt.pm * tstep : cA; const char* nB = has_next ? (const char*)g.Bt + (size_t)nxt.pn * tstep : cB;
        for (int t = 0; t < nt; t += 2) {
            const bool last = (t == nt - 2);
            const char* a1 = cA + (size_t)(t + 1) * kstep;
            const char* a2 = last ? nA : cA + (size_t)(t + 2) * kstep; const char* b2 = last ? nB : cB + (size_t)(t + 2) * kstep;
            const char* a3 = a2 + kstep; const char* b3 = b2 + kstep;
            if (last && has_next) S.a_ready(nxt);
            if constexpr (SP2) {
            PG8_LDB(B0, 0, 0); PG8_LDB(B1, 0, 1); PG8_SCHED; PG8_LDA(At, 0, 0); PG8_STAGE(PG8_SA(1, 1), a1 + hstep, voffA);
            PG8_WAIT_V(8); PG8_WAIT_L(0); PG8_BAR; PG8_MMA(0, 0, At, B0); PG8_MMA(0, 1, At, B1); PG8_BAR; PG8_SCHED;
            PG8_LDA(At, 0, 1); PG8_STAGE(PG8_SB(0, 0), b2, voffB); PG8_STAGE(PG8_SB(0, 1), b2 + hstep, voffB); PG8_STAGE(PG8_SA(0, 0), a2, voffA);
            PG8_WAIT_V(8); PG8_WAIT_L(0); PG8_BAR; PG8_MMA(1, 0, At, B0); PG8_MMA(1, 1, At, B1); PG8_BAR; PG8_SCHED;
            PG8_LDB(B0, 1, 0); PG8_LDB(B1, 1, 1); PG8_SCHED; PG8_LDA(At, 1, 0); PG8_STAGE(PG8_SA(0, 1), a2 + hstep, voffA);
            PG8_WAIT_V(8); PG8_WAIT_L(0); PG8_BAR; PG8_MMA(0, 0, At, B0); PG8_MMA(0, 1, At, B1); PG8_BAR; PG8_SCHED;
            PG8_LDA(At, 1, 1); PG8_STAGE(PG8_SB(1, 0), b3, voffB); PG8_STAGE(PG8_SB(1, 1), b3 + hstep, voffB); PG8_STAGE(PG8_SA(1, 0), a3, voffA);
            PG8_WAIT_V(8); PG8_WAIT_L(0); PG8_BAR; PG8_MMA(1, 0, At, B0); PG8_MMA(1, 1, At, B1); PG8_BAR; PG8_SCHED;
            } else {
            PG8_LDB(B0, 0, 0); PG8_SCHED; PG8_LDA(At, 0, 0); PG8_STAGE(PG8_SA(1, 1), a1 + hstep, voffA);
            PG8_WAIT_L(8); PG8_BAR; PG8_WAIT_L(0); PG8_MMA(0, 0, At, B0); PG8_BAR; PG8_SCHED;
            PG8_LDB(B1, 0, 1); PG8_STAGE(PG8_SB(0, 0), b2, voffB);
            PG8_BAR; PG8_WAIT_L(0); PG8_MMA(0, 1, At, B1); PG8_BAR;
            PG8_LDA(At, 0, 1); PG8_STAGE(PG8_SA(0, 0), a2, voffA);
            PG8_BAR; PG8_WAIT_L(0); PG8_MMA(1, 0, At, B0); PG8_BAR; PG8_SCHED;
            PG8_STAGE(PG8_SB(0, 1), b2 + hstep, voffB);
            PG8_WAIT_V(6); PG8_BAR; PG8_MMA(1, 1, At, B1); PG8_BAR;
            PG8_LDB(B0, 1, 0); PG8_SCHED; PG8_LDA(At, 1, 0); PG8_STAGE(PG8_SA(0, 1), a2 + hstep, voffA);
            PG8_WAIT_L(8); PG8_BAR; PG8_WAIT_L(0); PG8_MMA(0, 0, At, B0); PG8_BAR; PG8_SCHED;
            PG8_LDB(B1, 1, 1); PG8_STAGE(PG8_SB(1, 0), b3, voffB);
            PG8_BAR; PG8_WAIT_L(0); PG8_MMA(0, 1, At, B1); PG8_BAR;
            PG8_LDA(At, 1, 1); PG8_STAGE(PG8_SA(1, 0), a3, voffA);
            PG8_BAR; PG8_WAIT_L(0); PG8_MMA(1, 0, At, B0); PG8_BAR; PG8_SCHED;
            PG8_STAGE(PG8_SB(1, 1), b3 + hstep, voffB);
            PG8_WAIT_V(6); PG8_BAR; PG8_MMA(1, 1, At, B1); PG8_BAR;
            }
        }
        if constexpr (ALIGN_EPI) { if (wr == 0) PG8_BAR; }
        if constexpr (!Epi::AFTER_DRAIN) { E(acc, cur, wr, wc, fr, fq); S.done(cur); }
        if (!has_next) break;
#pragma unroll
        for (int a = 0; a < 2; ++a)
#pragma unroll
            for (int b = 0; b < 2; ++b)
#pragma unroll
                for (int m = 0; m < 4; ++m)
#pragma unroll
                    for (int n = 0; n < 2; ++n) acc[a][b][m][n] = (f32x4){0.f, 0.f, 0.f, 0.f};
        cur = nxt; cA = nA; cB = nB; ++ui;
        if constexpr (ALIGN_EPI) { if (wr == 1) PG8_BAR; }
    }
    PG8_WAIT_V(0);
    if constexpr (!ALIGN_EPI) { if (wr == 0) PG8_BAR; }
    PG8_BAR;
#undef PG8_SA
#undef PG8_SB
#undef PG8_STAGE
#undef PG8_LDA
#undef PG8_LDB
#undef PG8_MMA
#undef PG8_WAIT_V
#undef PG8_WAIT_L
#undef PG8_BAR
#undef PG8_SCHED
}
}

constexpr int NWAVES = 8;
constexpr int D = 4096, NB = 4, SEQ = 4096, M = NB * SEQ, FF = 11008;
constexpr int NGLU = 2 * D, NUP = 2 * FF, NQKV = 5120;
constexpr int S5G = 256, S5P = 64, S5C = 16;
constexpr float EPS = 1e-6f;

constexpr size_t MiB = 1u << 20;
constexpr size_t WS_CTL = 0, CTL_ZERO_BYTES = 1 * MiB;
constexpr size_t WS_RS = 1 * MiB;
constexpr size_t WS_WGLU = 2 * MiB, WS_WUP0 = 66 * MiB, WS_WDN0 = 238 * MiB, WS_WQKV = 324 * MiB, WS_WO = 364 * MiB, WS_WUP1 = 396 * MiB, WS_WDN1 = 568 * MiB;
constexpr size_t WS_HB = 654 * MiB, WS_GA = 782 * MiB, WS_MB = 910 * MiB, WS_ACT = 1038 * MiB, WS_END = 1382 * MiB;
constexpr size_t WS_Q = WS_ACT, WS_K = WS_ACT + 128 * MiB, WS_V = WS_ACT + 144 * MiB;
constexpr int CW_BAR = 4096;

constexpr int RING_OFF = 0, RING_BYTES = 131072;
constexpr int LDSCTL_OFF = RING_BYTES, MISC_OFF = LDSCTL_OFF + 320;
constexpr int LDS_BYTES = 147456;

#define GAS __attribute__((address_space(1)))
#define LAS __attribute__((address_space(3)))
typedef unsigned short bf16;
typedef unsigned v4u __attribute__((ext_vector_type(4)));
typedef unsigned v2u __attribute__((ext_vector_type(2)));
typedef float f32x4 __attribute__((ext_vector_type(4)));
typedef float f32x16 __attribute__((ext_vector_type(16)));
typedef short bf16x8 __attribute__((ext_vector_type(8)));
using bf16x2 = __attribute__((ext_vector_type(2))) __bf16;
typedef GAS unsigned gu32;
#define LDS_WAIT() asm volatile("s_waitcnt lgkmcnt(0)" ::: "memory")
#define VM_WAIT() asm volatile("s_waitcnt vmcnt(0)" ::: "memory")
__device__ __forceinline__ unsigned pk2(float lo, float hi) { return pg8::cvt_pk_bf16(lo, hi); }
__device__ __forceinline__ float bf_lo(unsigned w) { return __uint_as_float(w << 16); }
__device__ __forceinline__ float bf_hi(unsigned w) { return __uint_as_float(w & 0xffff0000u); }

#define XB_TMO      128
#define XB_XCNT(j)  (256  + 64 * (j))
#define XB_XSUB(j)  (1280 + 64 * (j))
#define XB_XGEN(j)  (2304 + 64 * (j))
#define XB_TOP      3328
#define XB_TOPGEN   3392
#define XCD_BAR_WORDS 3456
#define XB_SPIN_CAP (1u << 18)

__device__ __forceinline__ unsigned xb_ld(unsigned* p)              { return __hip_atomic_load(p, __ATOMIC_RELAXED, __HIP_MEMORY_SCOPE_AGENT); }
__device__ __forceinline__ unsigned xb_add(unsigned* p, unsigned v) { return __hip_atomic_fetch_add(p, v, __ATOMIC_RELAXED, __HIP_MEMORY_SCOPE_AGENT); }
__device__ __forceinline__ unsigned xb_xcc_id() { return (unsigned)__builtin_amdgcn_s_getreg((3 << 11) | 20) & 0xFu; }
#define XB_SPIN(cond, bar) do { unsigned _sp = 0; while (cond) { __builtin_amdgcn_s_sleep(1); \
    if ((++_sp & 255u) == 0u) { if (xb_ld(&(bar)[XB_TMO])) break; if (_sp > XB_SPIN_CAP) { atomicAdd(&(bar)[XB_TMO], 1u); break; } } } } while (0)

struct XcdBarrier {
    unsigned* bar; unsigned x;
    volatile LAS unsigned* st;
};
__device__ __forceinline__ XcdBarrier xcd_barrier_post(unsigned* bar, volatile LAS unsigned* st) {
    XcdBarrier b; b.bar = bar; b.x = xb_xcc_id(); b.st = st;
    if (threadIdx.x == 0) (void)xb_add(&bar[XB_XCNT(b.x)], 1u);
    return b;
}
__device__ __forceinline__ void xcd_barrier_complete(unsigned* bar, unsigned x, unsigned& nloc, unsigned& nx) {
    const unsigned G = gridDim.x * gridDim.y * gridDim.z;
    unsigned sum, cnt, mine, sp = 0u;
    for (;;) {
        sum = 0u; cnt = 0u; mine = 0u;
#pragma unroll
        for (unsigned j = 0; j < 16; ++j) { const unsigned c = xb_ld(&bar[XB_XCNT(j)]); sum += c; cnt += (c > 0u) ? 1u : 0u; mine = (j == x) ? c : mine; }
        if (sum == G) break;
        __builtin_amdgcn_s_sleep(1);
        if ((++sp & 255u) == 0u) { if (xb_ld(&bar[XB_TMO])) break; if (sp > XB_SPIN_CAP) { atomicAdd(&bar[XB_TMO], 1u); break; } }
    }
    nloc = mine > 0u ? mine : 1u; nx = cnt > 0u ? cnt : 1u;
}
__device__ __forceinline__ void xcd_barrier(const XcdBarrier& b) {
    asm volatile("s_waitcnt vmcnt(0)" ::: "memory");
    __syncthreads();
    if (threadIdx.x == 0) {
        unsigned* bar = b.bar;
        __builtin_amdgcn_s_waitcnt(0);
        unsigned nloc = b.st[0], nx = b.st[1];
        if (nloc == 0u) { xcd_barrier_complete(bar, b.x, nloc, nx); b.st[0] = nloc; b.st[1] = nx; }
        const unsigned old = xb_add(&bar[XB_XSUB(b.x)], 1u);
        const unsigned gen = old / nloc;
        if (old + 1u == (gen + 1u) * nloc) {
            __builtin_amdgcn_fence(__ATOMIC_RELEASE, "agent");
            asm volatile("s_waitcnt vmcnt(0)" ::: "memory");
            const unsigned og = xb_add(&bar[XB_TOP], 1u);
            const unsigned tg = og / nx;
            if (og + 1u == (tg + 1u) * nx) xb_add(&bar[XB_TOPGEN], 1u);
            else XB_SPIN(xb_ld(&bar[XB_TOPGEN]) == tg, bar);
            __builtin_amdgcn_fence(__ATOMIC_ACQUIRE, "agent");
            xb_add(&bar[XB_XGEN(b.x)], 1u);
            asm volatile("s_waitcnt vmcnt(0)" ::: "memory");
        } else {
            XB_SPIN(xb_ld(&bar[XB_XGEN(b.x)]) == gen, bar);
            __builtin_amdgcn_fence(__ATOMIC_ACQUIRE, "agent");
            asm volatile("s_waitcnt vmcnt(0)" ::: "memory");
        }
    }
    __syncthreads();
}

struct Frame {
    LAS unsigned char* lds;
    int tid, lane, wave;
    int vcu, G;
};
__device__ __forceinline__ float wave_sum(float v) {
#pragma unroll
    for (int o = 1; o < 64; o <<= 1) v += __shfl_xor(v, o);
    return v;
}

__device__ __forceinline__ void p0_item(const float* __restrict__ W, int K, int N, bf16* __restrict__ WT, int drow0, const float* __restrict__ gain, LAS float* scr, int k0, int n0, int lane) {
#pragma unroll 8
    for (int i = 0; i < 32; ++i) { const int kk = 2 * i + (lane >> 5); scr[kk * 33 + (lane & 31)] = W[(size_t)(k0 + kk) * N + n0 + (lane & 31)]; }
    LDS_WAIT(); asm volatile("" ::: "memory");
    const int c = lane & 7;
    float gk[8];
#pragma unroll
    for (int e = 0; e < 8; ++e) gk[e] = gain ? gain[k0 + 8 * c + e] : 1.0f;
#pragma unroll
    for (int j = 0; j < 4; ++j) { const int n = (lane >> 3) + 8 * j; const LAS float* s = scr + (8 * c) * 33 + n;
        v4u o; o.x = pk2(s[0 * 33] * gk[0], s[1 * 33] * gk[1]); o.y = pk2(s[2 * 33] * gk[2], s[3 * 33] * gk[3]); o.z = pk2(s[4 * 33] * gk[4], s[5 * 33] * gk[5]); o.w = pk2(s[6 * 33] * gk[6], s[7 * 33] * gk[7]);
        *(GAS v4u*)(WT + (size_t)(drow0 + n) * K + k0 + 8 * c) = o; }
    LDS_WAIT(); asm volatile("" ::: "memory");
}
__device__ __forceinline__ int map_pair(int n0, int bj) { return 256 * (n0 >> 7) + 128 * bj + (n0 & 127); }
__device__ __forceinline__ int map_qkv(int n0) { const int head = n0 >> 6, bj = (n0 >> 5) & 1; return 256 * (head >> 2) + 128 * bj + 32 * (head & 3); }

struct Args { const void* in[26]; float* out; unsigned char* ws; };

__device__ __forceinline__ void p0_prologue(Frame& F, const Args& A) {
    LAS float* scr = (LAS float*)(F.lds + RING_OFF + F.wave * 16384);
    const int gw = F.vcu * NWAVES + F.wave, NGW = F.G * NWAVES;
    unsigned char* ws = A.ws;
    constexpr int I_SQ = (D / 64) * (D / 32);
    constexpr int I_UP = (D / 64) * (FF / 32);
    constexpr int I_DN = (FF / 64) * (D / 32);
    constexpr int I_QKV = (D / 64) * (NQKV / 32);
    constexpr int NITEMS = 2 * I_SQ + 2 * (2 * I_UP + I_DN) + I_QKV + I_SQ;
    const float* npm = (const float*)A.in[2];
    const float* npf = (const float*)A.in[4];
    for (int it = gw; it < NITEMS; it += NGW) {
        int r = it;
        if (r < 2 * I_SQ) { const int bj = r >= I_SQ; r -= bj * I_SQ; const int nblk = D / 32, kb = r / nblk, nb = r % nblk;
            p0_item((const float*)A.in[bj ? 16 : 14], D, D, (bf16*)(ws + WS_WGLU), map_pair(32 * nb, bj), nullptr, scr, 64 * kb, 32 * nb, F.lane); continue; }
        r -= 2 * I_SQ;
        bool done = false;
#pragma unroll
        for (int l = 0; l < 2; ++l) {
            if (done) break;
            if (r < 2 * I_UP) { const int bj = r >= I_UP; r -= bj * I_UP; const int nblk = FF / 32, kb = r / nblk, nb = r % nblk;
                p0_item((const float*)A.in[bj ? 24 : 23] + (size_t)l * D * FF, D, FF, (bf16*)(ws + (l ? WS_WUP1 : WS_WUP0)), map_pair(32 * nb, bj), npf + l * D, scr, 64 * kb, 32 * nb, F.lane); done = true; break; }
            r -= 2 * I_UP;
            if (r < I_DN) { const int nblk = D / 32, kb = r / nblk, nb = r % nblk;
                p0_item((const float*)A.in[25] + (size_t)l * FF * D, FF, D, (bf16*)(ws + (l ? WS_WDN1 : WS_WDN0)), 32 * nb, nullptr, scr, 64 * kb, 32 * nb, F.lane); done = true; break; }
            r -= I_DN;
        }
        if (done) continue;
        if (r < I_QKV) { const int nblk = NQKV / 32, kb = r / nblk, nb = r % nblk;
            p0_item((const float*)A.in[18], D, NQKV, (bf16*)(ws + WS_WQKV), map_qkv(32 * nb), npm + D, scr, 64 * kb, 32 * nb, F.lane); continue; }
        r -= I_QKV;
        { const int nblk = D / 32, kb = r / nblk, nb = r % nblk;
            p0_item((const float*)A.in[20], D, D, (bf16*)(ws + WS_WO), 32 * nb, nullptr, scr, 64 * kb, 32 * nb, F.lane); }
    }
    const float* x = (const float*)A.in[0]; float* rs0 = (float*)(ws + WS_RS);
    for (int m = gw; m < M; m += NGW) {
        const GAS f32x4* xr = (const GAS f32x4*)(x + (size_t)m * D) + F.lane; float s = 0.f;
#pragma unroll
        for (int j = 0; j < 16; ++j) { const f32x4 v = xr[64 * j]; s += (v.x * v.x + v.y * v.y) + (v.z * v.z + v.w * v.w); }
        s = wave_sum(s);
        if (F.lane == 0) rs0[m] = 1.0f / sqrtf(s * (1.0f / D) + EPS);
    }
}

__device__ __forceinline__ bf16x8 pack8(const f32x4 a, const f32x4 b) {
    v4u w; w.x = pk2(a.x, a.y); w.y = pk2(a.z, a.w); w.z = pk2(b.x, b.y); w.w = pk2(b.z, b.w); return __builtin_bit_cast(bf16x8, w);
}
__device__ __forceinline__ float gelu_tanh(float y) {
    const float z = 0.7978845608028654f * (y + 0.044715f * y * y * y);
    return y * __builtin_amdgcn_rcpf(1.0f + __builtin_amdgcn_exp2f(-2.0f * 1.4426950408889634f * z));
}
__device__ __forceinline__ void s5_phase(Frame& F, const Args& A) {
    const float* x = (const float*)A.in[0]; const float* rs0 = (const float*)(A.ws + WS_RS); const float* gain = (const float*)A.in[2];
    const float* lam_re = (const float*)A.in[6]; const float* lam_im = (const float*)A.in[7]; const float* log_step = (const float*)A.in[8];
    const float* b_re = (const float*)A.in[9]; const float* b_im = (const float*)A.in[10]; const float* c_re = (const float*)A.in[11]; const float* c_im = (const float*)A.in[12];
    const float* dsk = (const float*)A.in[13]; bf16* G = (bf16*)(A.ws + WS_GA);
    const int lane = F.lane;
    LAS unsigned char* wl = F.lds + RING_OFF + F.wave * 20480;
    LAS float* U = (LAS float*)wl;
    LAS unsigned char* Sim = wl + 10240;
    const int n = lane & 31, h = lane >> 5;
    const int cc = lane & 15, kq = lane >> 4;
    for (int item = F.vcu + F.G * F.wave; item < 2 * S5G; item += F.G * NWAVES) {
        const int g = item & (S5G - 1), bp = item >> 8;
        const float stp = expf(log_step[g]);
        float lr[2], li[2]; bf16x8 Bf[4];
#pragma unroll
        for (int q = 0; q < 2; ++q) { const int p = n + 32 * q;
            const float are = lam_re[g * S5P + p], aim = lam_im[g * S5P + p];
            const float e = expf(are * stp); float sn, cs; sincosf(aim * stp, &sn, &cs);
            lr[q] = e * cs; li[q] = e * sn;
            const float nr = lr[q] - 1.0f, ni = li[q], den = 1.0f / (are * are + aim * aim);
            const float cr = (nr * are + ni * aim) * den, ci = (ni * are - nr * aim) * den;
            const float* brp = b_re + ((size_t)(g * S5P + p) * S5C + 8 * h); const float* bip = b_im + ((size_t)(g * S5P + p) * S5C + 8 * h);
            const f32x4 br0 = *(const f32x4*)brp, br1 = *(const f32x4*)(brp + 4), bi0 = *(const f32x4*)bip, bi1 = *(const f32x4*)(bip + 4);
            Bf[2 * q] = pack8(cr * br0 - ci * bi0, cr * br1 - ci * bi1);
            Bf[2 * q + 1] = pack8(cr * bi0 + ci * br0, cr * bi1 + ci * br1); }
        bf16x8 Cf[4];
#pragma unroll
        for (int ks = 0; ks < 4; ++ks) { const size_t o = (size_t)(g * S5C + cc) * S5P + 16 * ks + 4 * kq;
            const f32x4 cr4 = *(const f32x4*)(c_re + o), ci4 = *(const f32x4*)(c_im + o);
            v4u w; w.x = pk2(cr4.x, -ci4.x); w.y = pk2(cr4.y, -ci4.y); w.z = pk2(cr4.z, -ci4.z); w.w = pk2(cr4.w, -ci4.w); Cf[ks] = __builtin_bit_cast(bf16x8, w); }
        const f32x4 d4 = *(const f32x4*)(dsk + g * S5C + 4 * kq);
        const f32x4 gq = *(const f32x4*)(gain + g * S5C + 4 * (lane & 3));
        float sr[2] = {0.f, 0.f}, si[2] = {0.f, 0.f};
        f32x4 xv[8]; float rv[8];
#define S5_ISSUE(L0) do { _Pragma("unroll") for (int i = 0; i < 8; ++i) { const int row = i * 16 + (lane >> 2); const int grow = (2 * bp + (row >> 6)) * SEQ + (L0) + (row & 63); \
            xv[i] = *(const f32x4*)(x + (size_t)grow * D + g * S5C + 4 * (lane & 3)); rv[i] = rs0[grow]; } } while (0)
        S5_ISSUE(0);
        for (int L0 = 0; L0 < SEQ; L0 += 64) {
#pragma unroll
            for (int i = 0; i < 8; ++i) { const int row = i * 16 + (lane >> 2); *(LAS f32x4*)(U + row * 20 + 4 * (lane & 3)) = xv[i] * rv[i] * gq; }
            if (L0 + 64 < SEQ) S5_ISSUE(L0 + 64);
#pragma unroll 1
            for (int st = 0; st < 4; ++st) {
                const LAS float* up = U + (((n >> 2) & 1) * 64 + 16 * st + (n & 3) + 4 * (n >> 3)) * 20 + 8 * h;
                const bf16x8 Af = pack8(*(const LAS f32x4*)up, *(const LAS f32x4*)(up + 4));
                f32x16 acc[4];
#pragma unroll
                for (int nb = 0; nb < 4; ++nb) { f32x16 z;
#pragma unroll
                    for (int r = 0; r < 16; ++r) z[r] = 0.f;
                    acc[nb] = __builtin_amdgcn_mfma_f32_32x32x16_bf16(Af, Bf[nb], z, 0, 0, 0); }
#pragma unroll
                for (int r = 0; r < 16; ++r)
#pragma unroll
                    for (int q = 0; q < 2; ++q) {
                        const float nr = fmaf(lr[q], sr[q], fmaf(-li[q], si[q], acc[2 * q][r]));
                        const float ni = fmaf(lr[q], si[q], fmaf(li[q], sr[q], acc[2 * q + 1][r]));
                        sr[q] = nr; si[q] = ni;
                        *(LAS unsigned*)(Sim + (16 * h + r) * 288 + 4 * (n + 32 * q)) = pk2(nr, ni);
                    }
#pragma unroll
                for (int hb = 0; hb < 2; ++hb) {
                    f32x4 y = {0.f, 0.f, 0.f, 0.f};
#pragma unroll
                    for (int ks = 0; ks < 4; ++ks) { const bf16x8 sb = *(const LAS bf16x8*)(Sim + (16 * hb + cc) * 288 + (32 * ks + 8 * kq) * 2);
                        y = __builtin_amdgcn_mfma_f32_16x16x32_bf16(Cf[ks], sb, y, 0, 0, 0); }
                    const f32x4 u4 = *(const LAS f32x4*)(U + (hb * 64 + 16 * st + cc) * 20 + 4 * kq);
                    const f32x4 v = y + d4 * u4;
                    v2u w; w.x = pk2(gelu_tanh(v.x), gelu_tanh(v.y)); w.y = pk2(gelu_tanh(v.z), gelu_tanh(v.w));
                    *(GAS v2u*)(G + (size_t)((2 * bp + hb) * SEQ + L0 + 16 * st + cc) * D + g * S5C + 4 * kq) = w;
                }
            }
        }
#undef S5_ISSUE
    }
}

template <bool LAST>
__device__ __forceinline__ void resid_phase(Frame& F, const bf16* __restrict__ mb, const float* hprev, float* hout, bf16* __restrict__ hb, float* __restrict__ rs_out, const float* __restrict__ gain) {
    const int gw = F.vcu * NWAVES + F.wave, NGW = F.G * NWAVES, lane = F.lane;
    f32x4 gv[8][2];
#pragma unroll
    for (int j = 0; j < 8; ++j) { gv[j][0] = *(const f32x4*)(gain + j * 512 + lane * 8); gv[j][1] = *(const f32x4*)(gain + j * 512 + lane * 8 + 4); }
    for (int m = gw; m < M; m += NGW) {
        v4u mv[8]; f32x4 hv[8][2];
#pragma unroll
        for (int j = 0; j < 8; ++j) { mv[j] = *(const GAS v4u*)(mb + (size_t)m * D + j * 512 + lane * 8);
            hv[j][0] = *(const GAS f32x4*)(hprev + (size_t)m * D + j * 512 + lane * 8); hv[j][1] = *(const GAS f32x4*)(hprev + (size_t)m * D + j * 512 + lane * 8 + 4); }
        float s = 0.f;
#pragma unroll
        for (int j = 0; j < 8; ++j) { const float a0 = bf_lo(mv[j].x), a1 = bf_hi(mv[j].x), a2 = bf_lo(mv[j].y), a3 = bf_hi(mv[j].y), a4 = bf_lo(mv[j].z), a5 = bf_hi(mv[j].z), a6 = bf_lo(mv[j].w), a7 = bf_hi(mv[j].w);
            s += (a0 * a0 + a1 * a1) + (a2 * a2 + a3 * a3) + (a4 * a4 + a5 * a5) + (a6 * a6 + a7 * a7); }
        s = wave_sum(s);
        const float rm = 1.0f / sqrtf(s * (1.0f / D) + EPS);
        float s2 = 0.f;
#pragma unroll
        for (int j = 0; j < 8; ++j) {
            const f32x4 m0 = {bf_lo(mv[j].x), bf_hi(mv[j].x), bf_lo(mv[j].y), bf_hi(mv[j].y)}, m1 = {bf_lo(mv[j].z), bf_hi(mv[j].z), bf_lo(mv[j].w), bf_hi(mv[j].w)};
            const f32x4 h0 = hv[j][0] + m0 * rm * gv[j][0], h1 = hv[j][1] + m1 * rm * gv[j][1];
            s2 += (h0.x * h0.x + h0.y * h0.y) + (h0.z * h0.z + h0.w * h0.w) + (h1.x * h1.x + h1.y * h1.y) + (h1.z * h1.z + h1.w * h1.w);
            *(GAS f32x4*)(hout + (size_t)m * D + j * 512 + lane * 8) = h0; *(GAS f32x4*)(hout + (size_t)m * D + j * 512 + lane * 8 + 4) = h1;
            if (!LAST) { v4u o; o.x = pk2(h0.x, h0.y); o.y = pk2(h0.z, h0.w); o.z = pk2(h1.x, h1.y); o.w = pk2(h1.z, h1.w);
                *(GAS v4u*)(hb + (size_t)m * D + j * 512 + lane * 8) = o; }
        }
        if (!LAST) { s2 = wave_sum(s2); if (lane == 0) rs_out[m] = 1.0f / sqrtf(s2 * (1.0f / D) + EPS); }
    }
}

constexpr int AK_ROW = 144, AV_ROW = 528;
constexpr int AK_OFF = 0, AV_OFF = 256 * AK_ROW;
__device__ __forceinline__ void attn_phase(Frame& F, const Args& A) {
    const bf16* Q = (const bf16*)(A.ws + WS_Q); const bf16* Kg = (const bf16*)(A.ws + WS_K); const bf16* Vg = (const bf16*)(A.ws + WS_V); bf16* O = (bf16*)(A.ws + WS_GA);
    const float* sinks = (const float*)A.in[22];
    LAS unsigned char* Ks = F.lds + RING_OFF + AK_OFF; LAS unsigned char* Vt = F.lds + RING_OFF + AV_OFF;
    const int tid = F.tid, lane = F.lane, col = lane & 31, h = lane >> 5;
    constexpr float SC = 0.125f * 1.4426950408889634f;
    for (int unit = F.vcu; unit < NB * 8 * 32; unit += F.G) {
        const int b = unit >> 8, kvh = (unit >> 5) & 7, qblk = unit & 31;
        const int key0 = 128 * (qblk - 1);
        __syncthreads();
#pragma unroll
        for (int i = 0; i < 4; ++i) { const int t = tid + 512 * i, kr = t >> 3, c = t & 7; const int ks = key0 + kr;
            v4u v = {0u, 0u, 0u, 0u}; if (ks >= 0) v = *(const GAS v4u*)(Kg + (size_t)(b * SEQ + ks) * 512 + kvh * 64 + 8 * c);
            *(LAS v4u*)(Ks + kr * AK_ROW + 16 * c) = v; }
#pragma unroll
        for (int i = 0; i < 2; ++i) { const int t = tid + 512 * i, kp = t & 127, c = t >> 7; const int ka = 2 * kp, ks = key0 + ka;
            v4u va = {0u, 0u, 0u, 0u}, vb = {0u, 0u, 0u, 0u};
            if (ks >= 0) { va = *(const GAS v4u*)(Vg + (size_t)(b * SEQ + ks) * 512 + kvh * 64 + 8 * c); vb = *(const GAS v4u*)(Vg + (size_t)(b * SEQ + ks + 1) * 512 + kvh * 64 + 8 * c); }
            const int kap = ka & 15, pos = (ka & ~15) + 8 * ((kap >> 2) & 1) + 4 * (kap >> 3) + (kap & 3);
            LAS unsigned char* dst = Vt + (8 * c) * AV_ROW + pos * 2;
            *(LAS unsigned*)(dst + 0 * AV_ROW) = (va.x & 0xffffu) | (vb.x << 16); *(LAS unsigned*)(dst + 1 * AV_ROW) = (va.x >> 16) | (vb.x & 0xffff0000u);
            *(LAS unsigned*)(dst + 2 * AV_ROW) = (va.y & 0xffffu) | (vb.y << 16); *(LAS unsigned*)(dst + 3 * AV_ROW) = (va.y >> 16) | (vb.y & 0xffff0000u);
            *(LAS unsigned*)(dst + 4 * AV_ROW) = (va.z & 0xffffu) | (vb.z << 16); *(LAS unsigned*)(dst + 5 * AV_ROW) = (va.z >> 16) | (vb.z & 0xffff0000u);
            *(LAS unsigned*)(dst + 6 * AV_ROW) = (va.w & 0xffffu) | (vb.w << 16); *(LAS unsigned*)(dst + 7 * AV_ROW) = (va.w >> 16) | (vb.w & 0xffff0000u); }
        __syncthreads();
        const int head = kvh * 8 + F.wave;
        const float sink2 = sinks[head] * 1.4426950408889634f;
#pragma unroll 1
        for (int qs = 0; qs < 4; ++qs) {
            const size_t qrow = (size_t)(b * SEQ + 128 * qblk + 32 * qs + col);
            bf16x8 qf[4];
#pragma unroll
            for (int s4 = 0; s4 < 4; ++s4) qf[s4] = *(const GAS bf16x8*)(Q + qrow * D + head * 64 + 16 * s4 + 8 * h);
            f32x16 sc[5];
#pragma unroll
            for (int t = 0; t < 5; ++t) {
#pragma unroll
                for (int r = 0; r < 16; ++r) sc[t][r] = 0.f;
#pragma unroll
                for (int s4 = 0; s4 < 4; ++s4) { const bf16x8 kf = *(const LAS bf16x8*)(Ks + (32 * (qs + t) + col) * AK_ROW + (16 * s4 + 8 * h) * 2);
                    sc[t] = __builtin_amdgcn_mfma_f32_32x32x16_bf16(kf, qf[s4], sc[t], 0, 0, 0); }
            }
            float mloc = -1e30f;
#pragma unroll
            for (int t = 0; t < 5; ++t) { const bool tile_ok = (qblk > 0) || (qs + t >= 4);
#pragma unroll
                for (int r = 0; r < 16; ++r) { const int row = (r & 3) + 8 * (r >> 2) + 4 * h;
                    bool ok = tile_ok; if (t == 0) ok = ok && (row > col); if (t == 4) ok = ok && (row <= col);
                    const float v = ok ? sc[t][r] * SC : -1e30f; sc[t][r] = v; mloc = fmaxf(mloc, v); } }
            float m2 = fmaxf(mloc, __shfl_xor(mloc, 32)); m2 = fmaxf(m2, sink2);
            float lloc = 0.f;
#pragma unroll
            for (int t = 0; t < 5; ++t)
#pragma unroll
                for (int r = 0; r < 16; ++r) { const float p = __builtin_amdgcn_exp2f(sc[t][r] - m2); sc[t][r] = p; lloc += p; }
            const float l = lloc + __shfl_xor(lloc, 32) + __builtin_amdgcn_exp2f(sink2 - m2);
            f32x16 o[2];
#pragma unroll
            for (int r = 0; r < 16; ++r) { o[0][r] = 0.f; o[1][r] = 0.f; }
#pragma unroll
            for (int t = 0; t < 5; ++t)
#pragma unroll
                for (int s2 = 0; s2 < 2; ++s2) {
                    v4u pw; pw.x = pk2(sc[t][8 * s2 + 0], sc[t][8 * s2 + 1]); pw.y = pk2(sc[t][8 * s2 + 2], sc[t][8 * s2 + 3]); pw.z = pk2(sc[t][8 * s2 + 4], sc[t][8 * s2 + 5]); pw.w = pk2(sc[t][8 * s2 + 6], sc[t][8 * s2 + 7]);
                    const bf16x8 pb = __builtin_bit_cast(bf16x8, pw);
#pragma unroll
                    for (int db = 0; db < 2; ++db) { const bf16x8 vf = *(const LAS bf16x8*)(Vt + (32 * db + col) * AV_ROW + (32 * (qs + t) + 16 * s2 + 8 * h) * 2);
                        o[db] = __builtin_amdgcn_mfma_f32_32x32x16_bf16(vf, pb, o[db], 0, 0, 0); }
                }
            const float inv = 1.0f / l;
#pragma unroll
            for (int db = 0; db < 2; ++db)
#pragma unroll
                for (int g4 = 0; g4 < 4; ++g4) { v2u w; w.x = pk2(o[db][4 * g4] * inv, o[db][4 * g4 + 1] * inv); w.y = pk2(o[db][4 * g4 + 2] * inv, o[db][4 * g4 + 3] * inv);
                    *(GAS v2u*)(O + qrow * D + head * 64 + 32 * db + 8 * g4 + 4 * h) = w; }
        }
    }
    __syncthreads();
}

__global__ void __launch_bounds__(NWAVES * 64, 2) fwd(Args args) {
    extern __shared__ __attribute__((aligned(16))) unsigned char lds[];
    Frame F;
    F.lds = (LAS unsigned char*)lds;
    F.tid = threadIdx.x; F.lane = F.tid & 63; F.wave = __builtin_amdgcn_readfirstlane(F.tid >> 6);
    F.G = gridDim.x; { const int bx = blockIdx.x; F.vcu = (F.G % 8 == 0) ? (bx % 8) * (F.G / 8) + bx / 8 : bx; }
    unsigned char* ws = args.ws;
    for (int u = F.tid; u < (LDS_BYTES - LDSCTL_OFF) / 4; u += NWAVES * 64) ((LAS unsigned*)(F.lds + LDSCTL_OFF))[u] = 0u;
    __syncthreads();
    XcdBarrier bar = xcd_barrier_post((unsigned*)(ws + WS_CTL) + CW_BAR, (volatile LAS unsigned*)(F.lds + MISC_OFF) + 8);
    float* rs = (float*)(ws + WS_RS);
    const float* x = (const float*)args.in[0];
    bf16* HB = (bf16*)(ws + WS_HB); bf16* GA = (bf16*)(ws + WS_GA); bf16* MB = (bf16*)(ws + WS_MB); bf16* ACT = (bf16*)(ws + WS_ACT);
    const float* n_post_mix = (const float*)args.in[3]; const float* n_post_ffn = (const float*)args.in[5];

    p0_prologue(F, args); xcd_barrier(bar);
    s5_phase(F, args); xcd_barrier(bar);
    { pg8::Gemm g{GA, (const bf16*)(ws + WS_WGLU), M, NGLU, D}; pg8::StaticOrder S; S.init(M, NGLU, F.G, (int)blockIdx.x);
      pg8::EpiGlu E{MB, D, (const float*)args.in[15], (const float*)args.in[17]};
      pg8::gemm_phase<pg8::EpiGlu, pg8::StaticOrder, true, true>(F.lds + RING_OFF, g, S, E); }
    xcd_barrier(bar);
    resid_phase<false>(F, MB, x, args.out, HB, rs + M, n_post_mix); xcd_barrier(bar);

#define FFN_PHASES(layer) do { \
        { pg8::Gemm g{HB, (const bf16*)(ws + (layer ? WS_WUP1 : WS_WUP0)), M, NUP, D}; pg8::StaticOrder S; S.init(M, NUP, F.G, (int)blockIdx.x); \
          pg8::EpiSwiglu E{ACT, FF, rs + (layer ? 3 : 1) * M}; \
          pg8::gemm_phase<pg8::EpiSwiglu, pg8::StaticOrder, true, true>(F.lds + RING_OFF, g, S, E); } \
        xcd_barrier(bar); \
        { pg8::Gemm g{ACT, (const bf16*)(ws + (layer ? WS_WDN1 : WS_WDN0)), M, D, FF}; pg8::StaticOrder S; S.init(M, D, F.G, (int)blockIdx.x); \
          pg8::EpiPlain E{MB, D, nullptr}; \
          pg8::gemm_phase<pg8::EpiPlain, pg8::StaticOrder, true, true>(F.lds + RING_OFF, g, S, E); } \
        xcd_barrier(bar); } while (0)
    FFN_PHASES(0);
    resid_phase<false>(F, MB, args.out, args.out, HB, rs + 2 * M, n_post_ffn); xcd_barrier(bar);
            { pg8::Gemm g{HB, (const bf16*)(ws + WS_WQKV), M, NQKV, D}; pg8::StaticOrder S; S.init(M, NQKV, F.G, (int)blockIdx.x);
              pg8::EpiQkv E{(bf16*)(ws + WS_Q), (bf16*)(ws + WS_K), (bf16*)(ws + WS_V), rs + 2 * M, (const float*)args.in[19], (const int*)args.in[1]};
              pg8::gemm_phase<pg8::EpiQkv, pg8::StaticOrder, true, true>(F.lds + RING_OFF, g, S, E); }
            xcd_barrier(bar);
            attn_phase(F, args); xcd_barrier(bar);
            { pg8::Gemm g{GA, (const bf16*)(ws + WS_WO), M, D, D}; pg8::StaticOrder S; S.init(M, D, F.G, (int)blockIdx.x);
              pg8::EpiPlain E{MB, D, (const float*)args.in[21]};
              pg8::gemm_phase<pg8::EpiPlain, pg8::StaticOrder, true, true>(F.lds + RING_OFF, g, S, E); }
            xcd_barrier(bar);
            resid_phase<false>(F, MB, args.out, args.out, HB, rs + 3 * M, n_post_mix + D); xcd_barrier(bar);
    FFN_PHASES(1);
    resid_phase<true>(F, MB, args.out, args.out, HB, rs, n_post_ffn + D);
}
extern "C" void kernel_launch(void* const* d_in, const int* in_sizes, int n_in, void* d_out, int out_size, void* d_ws, size_t ws_size, hipStream_t stream) {
    static int grid = 0;
    if (grid == 0) {
        if (n_in != 26 || in_sizes[0] != M * D || out_size != M * D || ws_size < WS_END) { fprintf(stderr, "kernel_launch: unexpected shapes (n_in %d, in0 %d, out %d, ws %zu); nothing launched\n", n_in, n_in > 0 ? in_sizes[0] : -1, out_size, ws_size); grid = -1; return; }
        int dev = 0, cus = 0, per_cu = 0;
        if (hipGetDevice(&dev) != hipSuccess || hipDeviceGetAttribute(&cus, hipDeviceAttributeMultiprocessorCount, dev) != hipSuccess) { grid = -1; return; }
        if (hipFuncSetAttribute((const void*)fwd, hipFuncAttributeMaxDynamicSharedMemorySize, LDS_BYTES) != hipSuccess) { fprintf(stderr, "kernel_launch: hipFuncSetAttribute failed\n"); grid = -1; return; }
        if (hipOccupancyMaxActiveBlocksPerMultiprocessor(&per_cu, (const void*)fwd, NWAVES * 64, LDS_BYTES) != hipSuccess || per_cu < 1)
            fprintf(stderr, "kernel_launch: note: occupancy query reports %d workgroups per CU\n", per_cu);
        (void)hipGetLastError();
        grid = cus;
    }
    if (grid < 0) return;
    if (hipMemsetAsync((char*)d_ws + WS_CTL, 0, CTL_ZERO_BYTES, stream) != hipSuccess) { fprintf(stderr, "kernel_launch: hipMemsetAsync failed\n"); return; }
    Args a{};
    for (int i = 0; i < 26; ++i) a.in[i] = d_in[i];
    a.out = (float*)d_out; a.ws = (unsigned char*)d_ws;
    hipLaunchKernelGGL(fwd, dim3(grid), dim3(NWAVES * 64), LDS_BYTES, stream, a);
    const hipError_t le = hipPeekAtLastError();
    if (le != hipSuccess) fprintf(stderr, "kernel_launch: launch failed: %s\n", hipGetErrorName(le));
}
```

```cpp
#include <hip/hip_runtime.h>
#include <cstdio>
#include <cstdint>

namespace pg8 {
#define PG8_LAS __attribute__((address_space(3)))
typedef unsigned short bf16_t;
typedef short bf16x8 __attribute__((ext_vector_type(8)));
typedef float f32x4 __attribute__((ext_vector_type(4)));
typedef unsigned u32x4 __attribute__((ext_vector_type(4)));
constexpr int BM = 256, BK = 64, HALF = 128, HTB = HALF * BK * 2, STAGE_BYTES = 8 * HTB, NXCD = 8, WGM = 8;

__host__ __device__ __forceinline__ int lds_byte(int r, int c) { const int st = (r >> 4) * 2 + (c >> 5), rr = r & 15, cc = c & 31, ob = rr * 64 + cc * 2; return st * 1024 + (ob ^ (((ob >> 9) & 1) << 5)); }
__host__ __device__ __forceinline__ void stage_rc(int b, int& R, int& C) { const int st = b / 1024, sb = b % 1024, swz = sb ^ (((sb >> 9) & 1) << 5); R = (st >> 1) * 16 + swz / 64; C = (st & 1) * 32 + (swz % 64) / 2; }
__host__ __device__ __forceinline__ int perm32(int rho) { const int n = rho >> 4, i = rho & 15; return 8 * (i >> 2) + 4 * n + (i & 3); }

struct Unit { int pm, pn; };
struct Gemm { const bf16_t* A; const bf16_t* Bt; int M, N, K; };

struct StaticOrder {
    int nM, nN, nwg, G, c;
    __host__ __device__ void init(int M, int N, int G_, int c_) { nM = M / BM; nN = N / BM; nwg = nM * nN; G = G_; c = c_; }
    __host__ __device__ bool next(int i, Unit& u) const {
        const long L = (long)i * G + c; if (L >= nwg) return false;
        int wgid = (int)L; { const int q = nwg / NXCD, r = nwg % NXCD, xcd = wgid % NXCD, off = wgid / NXCD; wgid = (xcd < r ? xcd * (q + 1) : r * (q + 1) + (xcd - r) * q) + off; }
        const int nig = WGM * nN, gid = wgid / nig, fm = gid * WGM, gsz = (nM - fm) < WGM ? (nM - fm) : WGM;
        u.pm = fm + ((wgid % nig) % gsz); u.pn = (wgid % nig) / gsz; return true;
    }
    __device__ __forceinline__ void a_ready(const Unit&) const {}
    __device__ __forceinline__ void done(const Unit&) const {}
};

__device__ __forceinline__ unsigned cvt_pk_bf16(float lo, float hi) { unsigned r; asm volatile("v_cvt_pk_bf16_f32 %0, %1, %2" : "=v"(r) : "v"(lo), "v"(hi)); return r; }


struct EpiPlain {
    static constexpr bool PERM = true, AFTER_DRAIN = false;
    bf16_t* O; int ldc; const float* bias;
    __device__ __forceinline__ void operator()(const f32x4 (&acc)[2][2][4][2], const Unit& u, int wr, int wc, int fr, int fq) const {
        const int row0 = u.pm * BM + wr * 64 + fr; const int col0 = u.pn * BM + wc * 32 + 8 * fq;
        f32x4 bv[2][2];
#pragma unroll
        for (int bj = 0; bj < 2; ++bj)
#pragma unroll
            for (int n = 0; n < 2; ++n) bv[bj][n] = bias ? *(const f32x4*)(bias + col0 + bj * HALF + 4 * n) : (f32x4){0.f, 0.f, 0.f, 0.f};
#pragma unroll
        for (int ai = 0; ai < 2; ++ai)
#pragma unroll
            for (int m = 0; m < 4; ++m) { bf16_t* rowp = O + (size_t)(row0 + ai * HALF + m * 16) * ldc + col0;
#pragma unroll
                for (int bj = 0; bj < 2; ++bj) { const f32x4 v0 = acc[ai][bj][m][0] + bv[bj][0], v1 = acc[ai][bj][m][1] + bv[bj][1];
                    u32x4 w; w.x = cvt_pk_bf16(v0[0], v0[1]); w.y = cvt_pk_bf16(v0[2], v0[3]); w.z = cvt_pk_bf16(v1[0], v1[1]); w.w = cvt_pk_bf16(v1[2], v1[3]);
                    *(u32x4*)(rowp + bj * HALF) = w; } }
    }
};
__device__ __forceinline__ float sigmoid_f(float x) { return __builtin_amdgcn_rcpf(1.0f + __builtin_amdgcn_exp2f(-1.4426950408889634f * x)); }
struct EpiGlu {
    static constexpr bool PERM = true, AFTER_DRAIN = false;
    bf16_t* O; int ldc; const float* b1; const float* b2;
    __device__ __forceinline__ void operator()(const f32x4 (&acc)[2][2][4][2], const Unit& u, int wr, int wc, int fr, int fq) const {
        const int row0 = u.pm * BM + wr * 64 + fr; const int col0 = u.pn * HALF + wc * 32 + 8 * fq;
        f32x4 bv[2][2];
#pragma unroll
        for (int n = 0; n < 2; ++n) { bv[0][n] = *(const f32x4*)(b1 + col0 + 4 * n); bv[1][n] = *(const f32x4*)(b2 + col0 + 4 * n); }
#pragma unroll
        for (int ai = 0; ai < 2; ++ai)
#pragma unroll
            for (int m = 0; m < 4; ++m) { bf16_t* rowp = O + (size_t)(row0 + ai * HALF + m * 16) * ldc + col0;
                f32x4 o[2];
#pragma unroll
                for (int n = 0; n < 2; ++n) { const f32x4 a = acc[ai][0][m][n] + bv[0][n], g = acc[ai][1][m][n] + bv[1][n];
#pragma unroll
                    for (int j = 0; j < 4; ++j) o[n][j] = a[j] * sigmoid_f(g[j]); }
                u32x4 w; w.x = cvt_pk_bf16(o[0][0], o[0][1]); w.y = cvt_pk_bf16(o[0][2], o[0][3]); w.z = cvt_pk_bf16(o[1][0], o[1][1]); w.w = cvt_pk_bf16(o[1][2], o[1][3]);
                *(u32x4*)rowp = w; }
    }
};
struct EpiSwiglu {
    static constexpr bool PERM = true, AFTER_DRAIN = false;
    bf16_t* O; int ldc; const float* rstd;
    __device__ __forceinline__ void operator()(const f32x4 (&acc)[2][2][4][2], const Unit& u, int wr, int wc, int fr, int fq) const {
        const int row0 = u.pm * BM + wr * 64 + fr; const int col0 = u.pn * HALF + wc * 32 + 8 * fq;
#pragma unroll
        for (int ai = 0; ai < 2; ++ai)
#pragma unroll
            for (int m = 0; m < 4; ++m) { const int row = row0 + ai * HALF + m * 16; const float rs = rstd[row]; bf16_t* rowp = O + (size_t)row * ldc + col0;
                f32x4 o[2];
#pragma unroll
                for (int n = 0; n < 2; ++n) { const f32x4 g = acc[ai][0][m][n] * rs, up = acc[ai][1][m][n] * rs;
#pragma unroll
                    for (int j = 0; j < 4; ++j) o[n][j] = g[j] * sigmoid_f(g[j]) * up[j]; }
                u32x4 w; w.x = cvt_pk_bf16(o[0][0], o[0][1]); w.y = cvt_pk_bf16(o[0][2], o[0][3]); w.z = cvt_pk_bf16(o[1][0], o[1][1]); w.w = cvt_pk_bf16(o[1][2], o[1][3]);
                *(u32x4*)rowp = w; }
    }
};
struct EpiQkv {
    static constexpr bool PERM = true, AFTER_DRAIN = false;
    bf16_t* Q; bf16_t* Kb; bf16_t* Vb; const float* rstd; const float* bias; const int* pos;
    __device__ __forceinline__ void operator()(const f32x4 (&acc)[2][2][4][2], const Unit& u, int wr, int wc, int fr, int fq) const {
        const int row0 = u.pm * BM + wr * 64 + fr; const int head = 4 * u.pn + wc;
        bf16_t* base; int ld, hcol;
        if (head < 64) { base = Q; ld = 4096; hcol = head * 64; } else if (head < 72) { base = Kb; ld = 512; hcol = (head - 64) * 64; } else { base = Vb; ld = 512; hcol = (head - 72) * 64; }
        const bool rope = head < 72;
        f32x4 bv[2][2];
#pragma unroll
        for (int bj = 0; bj < 2; ++bj)
#pragma unroll
            for (int n = 0; n < 2; ++n) bv[bj][n] = *(const f32x4*)(bias + head * 64 + 32 * bj + 8 * fq + 4 * n);
        float invf[2][4];
#pragma unroll
        for (int n = 0; n < 2; ++n)
#pragma unroll
            for (int j = 0; j < 4; ++j) invf[n][j] = exp2f(-(float)(8 * fq + 4 * n + j) * (13.287712379549449f / 32.0f));
#pragma unroll
        for (int ai = 0; ai < 2; ++ai)
#pragma unroll
            for (int m = 0; m < 4; ++m) { const int row = row0 + ai * HALF + m * 16; const float rs = rstd[row]; const float p = (float)pos[row];
                f32x4 v[2][2];
#pragma unroll
                for (int bj = 0; bj < 2; ++bj)
#pragma unroll
                    for (int n = 0; n < 2; ++n) v[bj][n] = acc[ai][bj][m][n] * rs + bv[bj][n];
                if (rope) {
#pragma unroll
                    for (int n = 0; n < 2; ++n)
#pragma unroll
                        for (int j = 0; j < 4; ++j) { const float ang = p * invf[n][j]; const float t = __builtin_amdgcn_fractf(ang * 0.15915494309189535f);
                            const float sn = __builtin_amdgcn_sinf(t), cs = __builtin_amdgcn_cosf(t); const float x1 = v[0][n][j], x2 = v[1][n][j];
                            v[0][n][j] = x1 * cs - x2 * sn; v[1][n][j] = x2 * cs + x1 * sn; }
                }
                bf16_t* rowp = base + (size_t)row * ld + hcol + 8 * fq;
#pragma unroll
                for (int bj = 0; bj < 2; ++bj) { u32x4 w; w.x = cvt_pk_bf16(v[bj][0][0], v[bj][0][1]); w.y = cvt_pk_bf16(v[bj][0][2], v[bj][0][3]); w.z = cvt_pk_bf16(v[bj][1][0], v[bj][1][1]); w.w = cvt_pk_bf16(v[bj][1][2], v[bj][1][3]);
                    *(u32x4*)(rowp + 32 * bj) = w; } }
    }
};

template <class Epi, class Sched, bool ALIGN_EPI = false, bool SP2 = false>
__device__ __forceinline__ void gemm_phase(PG8_LAS unsigned char* lds, const Gemm g, const Sched& S, const Epi& E) {
    int tid = threadIdx.x; asm volatile("" : "+v"(tid));
    const int wid = __builtin_amdgcn_readfirstlane(tid >> 6), lane = tid & 63, wr = wid >> 2, wc = wid & 3, fr = lane & 15, fq = lane >> 4;
    const int K = g.K, nt = K / BK;
    unsigned voffA[2], voffB[2];
#pragma unroll
    for (int i = 0; i < 2; ++i) { int R, C; stage_rc(tid * 16 + i * 8192, R, C); const int Rb = Epi::PERM ? ((R & ~31) + perm32(R & 31)) : R;
        voffA[i] = (unsigned)(R * K + C) * 2u; voffB[i] = (unsigned)(Rb * K + C) * 2u; }
    const size_t kstep = (size_t)(BK * 2);
    const size_t hstep = (size_t)HALF * K * 2;
    const size_t tstep = 2 * hstep;
    const unsigned ldsw = (unsigned)wid * 1024u;
    const int aoff = lds_byte(wr * 64 + fr, fq * 8), boff = lds_byte(wc * 32 + fr, fq * 8);
#define PG8_SA(b, h) (((b) * 2 + (h)) * HTB)
#define PG8_SB(b, h) ((4 + (b) * 2 + (h)) * HTB)
#define PG8_STAGE(bufoff, gbase, voff) do { _Pragma("unroll") for (int _i = 0; _i < 2; ++_i) \
        __builtin_amdgcn_global_load_lds((const unsigned*)((const char*)(gbase) + (voff)[_i]), (PG8_LAS unsigned*)(lds + (bufoff) + ldsw + _i * 8192), 16, 0, 0); } while (0)
#define PG8_LDA(dst, b, h) do { _Pragma("unroll") for (int m = 0; m < 4; ++m) _Pragma("unroll") for (int k = 0; k < 2; ++k) dst[m][k] = *(const PG8_LAS bf16x8*)(lds + PG8_SA(b, h) + aoff + m * 2048 + k * 1024); } while (0)
#define PG8_LDB(dst, b, h) do { _Pragma("unroll") for (int n = 0; n < 2; ++n) _Pragma("unroll") for (int k = 0; k < 2; ++k) dst[n][k] = *(const PG8_LAS bf16x8*)(lds + PG8_SB(b, h) + boff + n * 2048 + k * 1024); } while (0)
#define PG8_MMA(ai, bj, At, Bt) do { __builtin_amdgcn_s_setprio(1); _Pragma("unroll") for (int m = 0; m < 4; ++m) _Pragma("unroll") for (int n = 0; n < 2; ++n) _Pragma("unroll") for (int k = 0; k < 2; ++k) \
        acc[ai][bj][m][n] = __builtin_amdgcn_mfma_f32_16x16x32_bf16(Bt[n][k], At[m][k], acc[ai][bj][m][n], 0, 0, 0); __builtin_amdgcn_s_setprio(0); } while (0)
#define PG8_WAIT_V(n) asm volatile("s_waitcnt vmcnt(" #n ")" ::: "memory")
#define PG8_WAIT_L(n) asm volatile("s_waitcnt lgkmcnt(" #n ")" ::: "memory")
#define PG8_BAR __builtin_amdgcn_s_barrier()
#define PG8_SCHED __builtin_amdgcn_sched_barrier(0)
    Unit cur, nxt; int ui = 0;
    if (!S.next(0, cur)) return;
    f32x4 acc[2][2][4][2];
#pragma unroll
    for (int a = 0; a < 2; ++a)
#pragma unroll
        for (int b = 0; b < 2; ++b)
#pragma unroll
            for (int m = 0; m < 4; ++m)
#pragma unroll
                for (int n = 0; n < 2; ++n) acc[a][b][m][n] = (f32x4){0.f, 0.f, 0.f, 0.f};
    bf16x8 At[4][2], B0[2][2], B1[2][2];
    const char* cA = (const char*)g.A + (size_t)cur.pm * tstep; const char* cB = (const char*)g.Bt + (size_t)cur.pn * tstep;
    S.a_ready(cur);
    if constexpr (SP2) {
        PG8_STAGE(PG8_SB(0, 0), cB, voffB); PG8_STAGE(PG8_SB(0, 1), cB + hstep, voffB); PG8_STAGE(PG8_SA(0, 0), cA, voffA); PG8_STAGE(PG8_SA(0, 1), cA + hstep, voffA);
        if (wr == 1) PG8_BAR;
        PG8_WAIT_V(2); PG8_BAR;
        PG8_STAGE(PG8_SB(1, 0), cB + kstep, voffB); PG8_STAGE(PG8_SA(1, 0), cA + kstep, voffA); PG8_STAGE(PG8_SB(1, 1), cB + hstep + kstep, voffB);
        PG8_WAIT_V(6); PG8_BAR;
    } else {
        PG8_STAGE(PG8_SB(0, 0), cB, voffB); PG8_STAGE(PG8_SA(0, 0), cA, voffA); PG8_STAGE(PG8_SB(0, 1), cB + hstep, voffB); PG8_STAGE(PG8_SA(0, 1), cA + hstep, voffA);
        if (wr == 1) PG8_BAR;
        PG8_WAIT_V(4); PG8_BAR;
        PG8_STAGE(PG8_SB(1, 0), cB + kstep, voffB); PG8_STAGE(PG8_SA(1, 0), cA + kstep, voffA); PG8_STAGE(PG8_SB(1, 1), cB + hstep + kstep, voffB);
        PG8_WAIT_V(6); PG8_BAR;
    }
    for (;;) {
        const bool has_next = S.next(ui + 1, nxt);
        const char* nA = has_next ? (const char*)g.A + (size_t)nxt.pm * tstep : cA; const char* nB = has_next ? (const char*)g.Bt + (size_t)nxt.pn * tstep : cB;
        for (int t = 0; t < nt; t += 2) {
            const bool last = (t == nt - 2);
            const char* a1 = cA + (size_t)(t + 1) * kstep;
            const char* a2 = last ? nA : cA + (size_t)(t + 2) * kstep; const char* b2 = last ? nB : cB + (size_t)(t + 2) * kstep;
            const char* a3 = a2 + kstep; const char* b3 = b2 + kstep;
            if (last && has_next) S.a_ready(nxt);
            if constexpr (SP2) {
            PG8_LDB(B0, 0, 0); PG8_LDB(B1, 0, 1); PG8_SCHED; PG8_LDA(At, 0, 0); PG8_STAGE(PG8_SA(1, 1), a1 + hstep, voffA);
            PG8_WAIT_V(8); PG8_WAIT_L(0); PG8_BAR; PG8_MMA(0, 0, At, B0); PG8_MMA(0, 1, At, B1); PG8_BAR; PG8_SCHED;
            PG8_LDA(At, 0, 1); PG8_STAGE(PG8_SB(0, 0), b2, voffB); PG8_STAGE(PG8_SB(0, 1), b2 + hstep, voffB); PG8_STAGE(PG8_SA(0, 0), a2, voffA);
            PG8_WAIT_V(8); PG8_WAIT_L(0); PG8_BAR; PG8_MMA(1, 0, At, B0); PG8_MMA(1, 1, At, B1); PG8_BAR; PG8_SCHED;
            PG8_LDB(B0, 1, 0); PG8_LDB(B1, 1, 1); PG8_SCHED; PG8_LDA(At, 1, 0); PG8_STAGE(PG8_SA(0, 1), a2 + hstep, voffA);
            PG8_WAIT_V(8); PG8_WAIT_L(0); PG8_BAR; PG8_MMA(0, 0, At, B0); PG8_MMA(0, 1, At, B1); PG8_BAR; PG8_SCHED;
            PG8_LDA(At, 1, 1); PG8_STAGE(PG8_SB(1, 0), b3, voffB); PG8_STAGE(PG8_SB(1, 1), b3 + hstep, voffB); PG8_STAGE(PG8_SA(1, 0), a3, voffA);
            PG8_WAIT_V(8); PG8_WAIT_L(0); PG8_BAR; PG8_MMA(1, 0, At, B0); PG8_MMA(1, 1, At, B1); PG8_BAR; PG8_SCHED;
            } else {
            PG8_LDB(B0, 0, 0); PG8_SCHED; PG8_LDA(At, 0, 0); PG8_STAGE(PG8_SA(1, 1), a1 + hstep, voffA);
            PG8_WAIT_L(8); PG8_BAR; PG8_WAIT_L(0); PG8_MMA(0, 0, At, B0); PG8_BAR; PG8_SCHED;
            PG8_LDB(B1, 0, 1); PG8_STAGE(PG8_SB(0, 0), b2, voffB);
            PG8_BAR; PG8_WAIT_L(0); PG8_MMA(0, 1, At, B1); PG8_BAR;
            PG8_LDA(At, 0, 1); PG8_STAGE(PG8_SA(0, 0), a2, voffA);
            PG8_BAR; PG8_WAIT_L(0); PG8_MMA(1, 0, At, B0); PG8_BAR; PG8_SCHED;
            PG8_STAGE(PG8_SB(0, 1), b2 + hstep, voffB);
            PG8_WAIT_V(6); PG8_BAR; PG8_MMA(1, 1, At, B1); PG8_BAR;
            PG8_LDB(B0, 1, 0); PG8_SCHED; PG8_LDA(At, 1, 0); PG8_STAGE(PG8_SA(0, 1), a2 + hstep, voffA);
            PG8_WAIT_L(8); PG8_BAR; PG8_WAIT_L(0); PG8_MMA(0, 0, At, B0); PG8_BAR; PG8_SCHED;
            PG8_LDB(B1, 1, 1); PG8_STAGE(PG8_SB(1, 0), b3, voffB);
            PG8_BAR; PG8_WAIT_L(0); PG8_MMA(0, 1, At, B1); PG8_BAR;
            PG8_LDA(At, 1, 1); PG8_STAGE(PG8_SA(1, 0), a3, voffA);
            PG8_BAR; PG8_WAIT_L(0); PG8_MMA(1, 0, At, B0); PG8_BAR; PG8_SCHED;
            PG8_STAGE(PG8_SB(1, 1), b3 + hstep, voffB);
            PG8_WAIT_V(6); PG8_BAR; PG8_MMA(1, 1, At, B1); PG8_BAR;
            }
        }
        if constexpr (ALIGN_EPI) { if (wr == 0) PG8_BAR; }
        if constexpr (!Epi::AFTER_DRAIN) { E(acc, cur, wr, wc, fr, fq); S.done(cur); }
        if (!has_next) break;
#pragma unroll
        for (int a = 0; a < 2; ++a)
#pragma unroll
            for (int b = 0; b < 2; ++b)
#pragma unroll
                for (int m = 0; m < 4; ++m)
#pragma unroll
                    for (int n = 0; n < 2; ++n) acc[a][b][m][n] = (f32x4){0.f, 0.f, 0.f, 0.f};
        cur = nxt; cA = nA; cB = nB; ++ui;
        if constexpr (ALIGN_EPI) { if (wr == 1) PG8_BAR; }
    }
    PG8_WAIT_V(0);
    if constexpr (!ALIGN_EPI) { if (wr == 0) PG8_BAR; }
    PG8_BAR;
#undef PG8_SA
#undef PG8_SB
#undef PG8_STAGE
#undef PG8_LDA
#undef PG8_LDB
#undef PG8_MMA
#undef PG8_WAIT_V
#undef PG8_WAIT_L
#undef PG8_BAR
#undef PG8_SCHED
}
}

constexpr int NWAVES = 8;
constexpr int D = 4096, NB = 4, SEQ = 4096, M = NB * SEQ, FF = 11008;
constexpr int NGLU = 2 * D, NUP = 2 * FF, NQKV = 5120;
constexpr int S5G = 256, S5P = 64, S5C = 16;
constexpr float EPS = 1e-6f;

constexpr size_t MiB = 1u << 20;
constexpr size_t WS_CTL = 0, CTL_ZERO_BYTES = 1 * MiB;
constexpr size_t WS_RS = 1 * MiB;
constexpr size_t WS_WGLU = 2 * MiB, WS_WUP0 = 66 * MiB, WS_WDN0 = 238 * MiB, WS_WQKV = 324 * MiB, WS_WO = 364 * MiB, WS_WUP1 = 396 * MiB, WS_WDN1 = 568 * MiB;
constexpr size_t WS_HB = 654 * MiB, WS_GA = 782 * MiB, WS_MB = 910 * MiB, WS_ACT = 1038 * MiB, WS_END = 1382 * MiB;
constexpr size_t WS_Q = WS_ACT, WS_K = WS_ACT + 128 * MiB, WS_V = WS_ACT + 144 * MiB;
constexpr int CW_BAR = 4096;

constexpr int RING_OFF = 0, RING_BYTES = 131072;
constexpr int LDSCTL_OFF = RING_BYTES, MISC_OFF = LDSCTL_OFF + 320;
constexpr int LDS_BYTES = 147456;

#define GAS __attribute__((address_space(1)))
#define LAS __attribute__((address_space(3)))
typedef unsigned short bf16;
typedef unsigned v4u __attribute__((ext_vector_type(4)));
typedef unsigned v2u __attribute__((ext_vector_type(2)));
typedef float f32x4 __attribute__((ext_vector_type(4)));
typedef float f32x16 __attribute__((ext_vector_type(16)));
typedef short bf16x8 __attribute__((ext_vector_type(8)));
using bf16x2 = __attribute__((ext_vector_type(2))) __bf16;
typedef GAS unsigned gu32;
#define LDS_WAIT() asm volatile("s_waitcnt lgkmcnt(0)" ::: "memory")
#define VM_WAIT() asm volatile("s_waitcnt vmcnt(0)" ::: "memory")
__device__ __forceinline__ unsigned pk2(float lo, float hi) { return pg8::cvt_pk_bf16(lo, hi); }
__device__ __forceinline__ float bf_lo(unsigned w) { return __uint_as_float(w << 16); }
__device__ __forceinline__ float bf_hi(unsigned w) { return __uint_as_float(w & 0xffff0000u); }

#define XB_TMO      128
#define XB_XCNT(j)  (256  + 64 * (j))
#define XB_XSUB(j)  (1280 + 64 * (j))
#define XB_XGEN(j)  (2304 + 64 * (j))
#define XB_TOP      3328
#define XB_TOPGEN   3392
#define XCD_BAR_WORDS 3456
#define XB_SPIN_CAP (1u << 18)

__device__ __forceinline__ unsigned xb_ld(unsigned* p)              { return __hip_atomic_load(p, __ATOMIC_RELAXED, __HIP_MEMORY_SCOPE_AGENT); }
__device__ __forceinline__ unsigned xb_add(unsigned* p, unsigned v) { return __hip_atomic_fetch_add(p, v, __ATOMIC_RELAXED, __HIP_MEMORY_SCOPE_AGENT); }
__device__ __forceinline__ unsigned xb_xcc_id() { return (unsigned)__builtin_amdgcn_s_getreg((3 << 11) | 20) & 0xFu; }
#define XB_SPIN(cond, bar) do { unsigned _sp = 0; while (cond) { __builtin_amdgcn_s_sleep(1); \
    if ((++_sp & 255u) == 0u) { if (xb_ld(&(bar)[XB_TMO])) break; if (_sp > XB_SPIN_CAP) { atomicAdd(&(bar)[XB_TMO], 1u); break; } } } } while (0)

struct XcdBarrier {
    unsigned* bar; unsigned x;
    volatile LAS unsigned* st;
};
__device__ __forceinline__ XcdBarrier xcd_barrier_post(unsigned* bar, volatile LAS unsigned* st) {
    XcdBarrier b; b.bar = bar; b.x = xb_xcc_id(); b.st = st;
    if (threadIdx.x == 0) (void)xb_add(&bar[XB_XCNT(b.x)], 1u);
    return b;
}
__device__ __forceinline__ void xcd_barrier_complete(unsigned* bar, unsigned x, unsigned& nloc, unsigned& nx) {
    const unsigned G = gridDim.x * gridDim.y * gridDim.z;
    unsigned sum, cnt, mine, sp = 0u;
    for (;;) {
        sum = 0u; cnt = 0u; mine = 0u;
#pragma unroll
        for (unsigned j = 0; j < 16; ++j) { const unsigned c = xb_ld(&bar[XB_XCNT(j)]); sum += c; cnt += (c > 0u) ? 1u : 0u; mine = (j == x) ? c : mine; }
        if (sum == G) break;
        __builtin_amdgcn_s_sleep(1);
        if ((++sp & 255u) == 0u) { if (xb_ld(&bar[XB_TMO])) break; if (sp > XB_SPIN_CAP) { atomicAdd(&bar[XB_TMO], 1u); break; } }
    }
    nloc = mine > 0u ? mine : 1u; nx = cnt > 0u ? cnt : 1u;
}
__device__ __forceinline__ void xcd_barrier(const XcdBarrier& b) {
    asm volatile("s_waitcnt vmcnt(0)" ::: "memory");
    __syncthreads();
    if (threadIdx.x == 0) {
        unsigned* bar = b.bar;
        __builtin_amdgcn_s_waitcnt(0);
        unsigned nloc = b.st[0], nx = b.st[1];
        if (nloc == 0u) { xcd_barrier_complete(bar, b.x, nloc, nx); b.st[0] = nloc; b.st[1] = nx; }
        const unsigned old = xb_add(&bar[XB_XSUB(b.x)], 1u);
        const unsigned gen = old / nloc;
        if (old + 1u == (gen + 1u) * nloc) {
            __builtin_amdgcn_fence(__ATOMIC_RELEASE, "agent");
            asm volatile("s_waitcnt vmcnt(0)" ::: "memory");
            const unsigned og = xb_add(&bar[XB_TOP], 1u);
            const unsigned tg = og / nx;
            if (og + 1u == (tg + 1u) * nx) xb_add(&bar[XB_TOPGEN], 1u);
            else XB_SPIN(xb_ld(&bar[XB_TOPGEN]) == tg, bar);
            __builtin_amdgcn_fence(__ATOMIC_ACQUIRE, "agent");
            xb_add(&bar[XB_XGEN(b.x)], 1u);
            asm volatile("s_waitcnt vmcnt(0)" ::: "memory");
        } else {
            XB_SPIN(xb_ld(&bar[XB_XGEN(b.x)]) == gen, bar);
            __builtin_amdgcn_fence(__ATOMIC_ACQUIRE, "agent");
            asm volatile("s_waitcnt vmcnt(0)" ::: "memory");
        }
    }
    __syncthreads();
}

struct Frame {
    LAS unsigned char* lds;
    int tid, lane, wave;
    int vcu, G;
};
__device__ __forceinline__ void refresh(Frame& F) { int t = threadIdx.x; asm volatile("" : "+v"(t)); F.tid = t; F.lane = t & 63; F.wave = __builtin_amdgcn_readfirstlane(t >> 6); }
__device__ __forceinline__ float wave_sum(float v) {
#pragma unroll
    for (int o = 1; o < 64; o <<= 1) v += __shfl_xor(v, o);
    return v;
}

__device__ __forceinline__ void p0_item(const float* __restrict__ W, int K, int N, bf16* __restrict__ WT, int drow0, const float* __restrict__ gain, LAS float* scr, int k0, int n0, int lane) {
#pragma unroll 8
    for (int i = 0; i < 32; ++i) { const int kk = 2 * i + (lane >> 5); scr[kk * 33 + (lane & 31)] = W[(size_t)(k0 + kk) * N + n0 + (lane & 31)]; }
    LDS_WAIT(); asm volatile("" ::: "memory");
    const int c = lane & 7;
    float gk[8];
#pragma unroll
    for (int e = 0; e < 8; ++e) gk[e] = gain ? gain[k0 + 8 * c + e] : 1.0f;
#pragma unroll
    for (int j = 0; j < 4; ++j) { const int n = (lane >> 3) + 8 * j; const LAS float* s = scr + (8 * c) * 33 + n;
        v4u o; o.x = pk2(s[0 * 33] * gk[0], s[1 * 33] * gk[1]); o.y = pk2(s[2 * 33] * gk[2], s[3 * 33] * gk[3]); o.z = pk2(s[4 * 33] * gk[4], s[5 * 33] * gk[5]); o.w = pk2(s[6 * 33] * gk[6], s[7 * 33] * gk[7]);
        *(GAS v4u*)(WT + (size_t)(drow0 + n) * K + k0 + 8 * c) = o; }
    LDS_WAIT(); asm volatile("" ::: "memory");
}
__device__ __forceinline__ int map_pair(int n0, int bj) { return 256 * (n0 >> 7) + 128 * bj + (n0 & 127); }
__device__ __forceinline__ int map_qkv(int n0) { const int head = n0 >> 6, bj = (n0 >> 5) & 1; return 256 * (head >> 2) + 128 * bj + 32 * (head & 3); }

struct Args { const void* in[26]; float* out; unsigned char* ws; };
typedef const __attribute__((address_space(4))) Args* KArgs;
__device__ __forceinline__ KArgs kargs() { KArgs p = (KArgs)__builtin_amdgcn_kernarg_segment_ptr(); asm volatile("" : "+s"(p)); return p; }

__device__ __forceinline__ void p0_prologue(Frame& F) {
    refresh(F);
    const KArgs A_ = kargs();
    LAS float* scr = (LAS float*)(F.lds + RING_OFF + F.wave * 16384);
    const int gw = F.vcu * NWAVES + F.wave, NGW = F.G * NWAVES;
    unsigned char* ws = A_->ws;
    constexpr int I_SQ = (D / 64) * (D / 32);
    constexpr int I_UP = (D / 64) * (FF / 32);
    constexpr int I_DN = (FF / 64) * (D / 32);
    constexpr int I_QKV = (D / 64) * (NQKV / 32);
    constexpr int NITEMS = 2 * I_SQ + 2 * (2 * I_UP + I_DN) + I_QKV + I_SQ;
    const float* npm = (const float*)A_->in[2];
    const float* npf = (const float*)A_->in[4];
    for (int it = gw; it < NITEMS; it += NGW) {
        int r = it;
        if (r < 2 * I_SQ) { const int bj = r >= I_SQ; r -= bj * I_SQ; const int nblk = D / 32, kb = r / nblk, nb = r % nblk;
            p0_item((const float*)A_->in[bj ? 16 : 14], D, D, (bf16*)(ws + WS_WGLU), map_pair(32 * nb, bj), nullptr, scr, 64 * kb, 32 * nb, F.lane); continue; }
        r -= 2 * I_SQ;
        bool done = false;
#pragma unroll
        for (int l = 0; l < 2; ++l) {
            if (done) break;
            if (r < 2 * I_UP) { const int bj = r >= I_UP; r -= bj * I_UP; const int nblk = FF / 32, kb = r / nblk, nb = r % nblk;
                p0_item((const float*)A_->in[bj ? 24 : 23] + (size_t)l * D * FF, D, FF, (bf16*)(ws + (l ? WS_WUP1 : WS_WUP0)), map_pair(32 * nb, bj), npf + l * D, scr, 64 * kb, 32 * nb, F.lane); done = true; break; }
            r -= 2 * I_UP;
            if (r < I_DN) { const int nblk = D / 32, kb = r / nblk, nb = r % nblk;
                p0_item((const float*)A_->in[25] + (size_t)l * FF * D, FF, D, (bf16*)(ws + (l ? WS_WDN1 : WS_WDN0)), 32 * nb, nullptr, scr, 64 * kb, 32 * nb, F.lane); done = true; break; }
            r -= I_DN;
        }
        if (done) continue;
        if (r < I_QKV) { const int nblk = NQKV / 32, kb = r / nblk, nb = r % nblk;
            p0_item((const float*)A_->in[18], D, NQKV, (bf16*)(ws + WS_WQKV), map_qkv(32 * nb), npm + D, scr, 64 * kb, 32 * nb, F.lane); continue; }
        r -= I_QKV;
        { const int nblk = D / 32, kb = r / nblk, nb = r % nblk;
            p0_item((const float*)A_->in[20], D, D, (bf16*)(ws + WS_WO), 32 * nb, nullptr, scr, 64 * kb, 32 * nb, F.lane); }
    }
    const float* x = (const float*)A_->in[0]; float* rs0 = (float*)(ws + WS_RS);
    for (int m = gw; m < M; m += NGW) {
        const GAS f32x4* xr = (const GAS f32x4*)(x + (size_t)m * D) + F.lane; float s = 0.f;
#pragma unroll
        for (int j = 0; j < 16; ++j) { const f32x4 v = xr[64 * j]; s += (v.x * v.x + v.y * v.y) + (v.z * v.z + v.w * v.w); }
        s = wave_sum(s);
        if (F.lane == 0) rs0[m] = 1.0f / sqrtf(s * (1.0f / D) + EPS);
    }
}

__device__ __forceinline__ bf16x8 pack8(const f32x4 a, const f32x4 b) {
    v4u w; w.x = pk2(a.x, a.y); w.y = pk2(a.z, a.w); w.z = pk2(b.x, b.y); w.w = pk2(b.z, b.w); return __builtin_bit_cast(bf16x8, w);
}
__device__ __forceinline__ float gelu_tanh(float y) {
    const float z = 0.7978845608028654f * (y + 0.044715f * y * y * y);
    return y * __builtin_amdgcn_rcpf(1.0f + __builtin_amdgcn_exp2f(-2.0f * 1.4426950408889634f * z));
}
template <bool FULL>
__device__ __forceinline__ void s5_run(const float* __restrict__ x, const float* __restrict__ rs0, bf16* __restrict__ G, LAS float* U, LAS unsigned char* Sim, int g, int bp, int t0, int nt, int lane,
                                       const bf16x8 (&Bf)[4], const bf16x8 (&Cf)[4], const float (&lr)[2], const float (&li)[2], f32x4 d4, f32x4 gq, float (&sr)[2], float (&si)[2]) {
    const int n = lane & 31, h = lane >> 5, cc = lane & 15, kq = lane >> 4;
    f32x4 xv[4]; float rv[4];
#define S5_ISSUE(L0) do { _Pragma("unroll") for (int i = 0; i < 4; ++i) { const int row = i * 16 + (lane >> 2); const int grow = (2 * bp + (row >> 5)) * SEQ + (L0) + (row & 31); \
        xv[i] = *(const f32x4*)(x + (size_t)grow * D + g * S5C + 4 * (lane & 3)); rv[i] = rs0[grow]; } } while (0)
    S5_ISSUE(t0);
    for (int L0 = t0; L0 < t0 + nt; L0 += 32) {
#pragma unroll
        for (int i = 0; i < 4; ++i) { const int row = i * 16 + (lane >> 2); *(LAS f32x4*)(U + row * 20 + 4 * (lane & 3)) = xv[i] * rv[i] * gq; }
        if (L0 + 32 < t0 + nt) S5_ISSUE(L0 + 32);
#pragma unroll 1
        for (int st = 0; st < 2; ++st) {
            const LAS float* up = U + (((n >> 2) & 1) * 32 + 16 * st + (n & 3) + 4 * (n >> 3)) * 20 + 8 * h;
            const bf16x8 Af = pack8(*(const LAS f32x4*)up, *(const LAS f32x4*)(up + 4));
            f32x16 acc[4];
#pragma unroll
            for (int nb = 0; nb < 4; ++nb) { f32x16 z;
#pragma unroll
                for (int r = 0; r < 16; ++r) z[r] = 0.f;
                acc[nb] = __builtin_amdgcn_mfma_f32_32x32x16_bf16(Af, Bf[nb], z, 0, 0, 0); }
#pragma unroll
            for (int r = 0; r < 16; ++r)
#pragma unroll
                for (int q = 0; q < 2; ++q) {
                    const float nr = fmaf(lr[q], sr[q], fmaf(-li[q], si[q], acc[2 * q][r]));
                    const float ni = fmaf(lr[q], si[q], fmaf(li[q], sr[q], acc[2 * q + 1][r]));
                    sr[q] = nr; si[q] = ni;
                    if (FULL) *(LAS unsigned*)(Sim + (16 * h + r) * 288 + 4 * (n + 32 * q)) = pk2(nr, ni);
                }
            if (FULL) {
#pragma unroll
                for (int hb = 0; hb < 2; ++hb) {
                    f32x4 y = {0.f, 0.f, 0.f, 0.f};
#pragma unroll
                    for (int ks = 0; ks < 4; ++ks) { const bf16x8 sb = *(const LAS bf16x8*)(Sim + (16 * hb + cc) * 288 + (32 * ks + 8 * kq) * 2);
                        y = __builtin_amdgcn_mfma_f32_16x16x32_bf16(Cf[ks], sb, y, 0, 0, 0); }
                    const f32x4 u4 = *(const LAS f32x4*)(U + (hb * 32 + 16 * st + cc) * 20 + 4 * kq);
                    const f32x4 v = y + d4 * u4;
                    v2u w; w.x = pk2(gelu_tanh(v.x), gelu_tanh(v.y)); w.y = pk2(gelu_tanh(v.z), gelu_tanh(v.w));
                    *(GAS v2u*)(G + (size_t)((2 * bp + hb) * SEQ + L0 + 16 * st + cc) * D + g * S5C + 4 * kq) = w;
                }
            }
        }
    }
#undef S5_ISSUE
}
__device__ __forceinline__ void s5_phase(Frame& F) {
    refresh(F);
    const KArgs A_ = kargs();
    const float* x = (const float*)A_->in[0]; const float* rs0 = (const float*)(A_->ws + WS_RS); const float* gain = (const float*)A_->in[2];
    const float* lam_re = (const float*)A_->in[6]; const float* lam_im = (const float*)A_->in[7]; const float* log_step = (const float*)A_->in[8];
    const float* b_re = (const float*)A_->in[9]; const float* b_im = (const float*)A_->in[10]; const float* c_re = (const float*)A_->in[11]; const float* c_im = (const float*)A_->in[12];
    const float* dsk = (const float*)A_->in[13]; bf16* G = (bf16*)(A_->ws + WS_GA);
    const int lane = F.lane, w = F.wave, bp = w >> 2, seg = w & 3;
    constexpr int SEGT = SEQ / 4;
    LAS unsigned char* wl = F.lds + RING_OFF + w * 14336;
    LAS float* U = (LAS float*)wl;
    LAS unsigned char* Sim = wl + 5120;
    LAS float* E = (LAS float*)(F.lds + RING_OFF + 8 * 14336);
    const int n = lane & 31, h = lane >> 5, cc = lane & 15, kq = lane >> 4;
    for (int g = F.vcu; g < S5G; g += F.G) {
        const float stp = expf(log_step[g]);
        float lr[2], li[2], Lr[2], Li[2]; bf16x8 Bf[4];
#pragma unroll
        for (int q = 0; q < 2; ++q) { const int p = n + 32 * q;
            const float are = lam_re[g * S5P + p], aim = lam_im[g * S5P + p];
            const float zr = are * stp, zi = aim * stp;
            const float e = expf(zr); float sn, cs; sincosf(zi, &sn, &cs);
            lr[q] = e * cs; li[q] = e * sn;
            const float e2 = expf(zr * (float)SEGT); float sn2, cs2; sincosf(zi * (float)SEGT, &sn2, &cs2);
            Lr[q] = e2 * cs2; Li[q] = e2 * sn2;
            const float nr = lr[q] - 1.0f, ni = li[q], den = 1.0f / (are * are + aim * aim);
            const float cr = (nr * are + ni * aim) * den, ci = (ni * are - nr * aim) * den;
            const float* brp = b_re + ((size_t)(g * S5P + p) * S5C + 8 * h); const float* bip = b_im + ((size_t)(g * S5P + p) * S5C + 8 * h);
            const f32x4 br0 = *(const f32x4*)brp, br1 = *(const f32x4*)(brp + 4), bi0 = *(const f32x4*)bip, bi1 = *(const f32x4*)(bip + 4);
            Bf[2 * q] = pack8(cr * br0 - ci * bi0, cr * br1 - ci * bi1);
            Bf[2 * q + 1] = pack8(cr * bi0 + ci * br0, cr * bi1 + ci * br1); }
        bf16x8 Cf[4];
#pragma unroll
        for (int ks = 0; ks < 4; ++ks) { const size_t o = (size_t)(g * S5C + cc) * S5P + 16 * ks + 4 * kq;
            const f32x4 cr4 = *(const f32x4*)(c_re + o), ci4 = *(const f32x4*)(c_im + o);
            v4u wv; wv.x = pk2(cr4.x, -ci4.x); wv.y = pk2(cr4.y, -ci4.y); wv.z = pk2(cr4.z, -ci4.z); wv.w = pk2(cr4.w, -ci4.w); Cf[ks] = __builtin_bit_cast(bf16x8, wv); }
        const f32x4 d4 = *(const f32x4*)(dsk + g * S5C + 4 * kq);
        const f32x4 gq = *(const f32x4*)(gain + g * S5C + 4 * (lane & 3));
        float sr[2] = {0.f, 0.f}, si[2] = {0.f, 0.f};
        if (seg < 3) s5_run<false>(x, rs0, G, U, Sim, g, bp, seg * SEGT, SEGT, lane, Bf, Cf, lr, li, d4, gq, sr, si);
#pragma unroll
        for (int q = 0; q < 2; ++q) { E[((w * 2 + q) * 2 + 0) * 64 + lane] = sr[q]; E[((w * 2 + q) * 2 + 1) * 64 + lane] = si[q]; }
        __syncthreads();
        sr[0] = sr[1] = si[0] = si[1] = 0.f;
        for (int j = 0; j < seg; ++j) {
#pragma unroll
            for (int q = 0; q < 2; ++q) { const float er = E[(((bp * 4 + j) * 2 + q) * 2 + 0) * 64 + lane], ei = E[(((bp * 4 + j) * 2 + q) * 2 + 1) * 64 + lane];
                const float nr = Lr[q] * sr[q] - Li[q] * si[q] + er, ni = Lr[q] * si[q] + Li[q] * sr[q] + ei; sr[q] = nr; si[q] = ni; }
        }
        s5_run<true>(x, rs0, G, U, Sim, g, bp, seg * SEGT, SEGT, lane, Bf, Cf, lr, li, d4, gq, sr, si);
        __syncthreads();
    }
}

template <int MODE>
__device__ __forceinline__ void resid_phase(Frame& F, const bf16* __restrict__ mb, const float* __restrict__ xin, bf16* hb, float* __restrict__ outp, float* __restrict__ rs_out, const float* __restrict__ gain) {
    refresh(F);
    const int gw = F.vcu * NWAVES + F.wave, NGW = F.G * NWAVES, lane = F.lane;
    LAS float* gl = (LAS float*)(F.lds + RING_OFF);
    for (int i = F.tid; i < D / 4; i += NWAVES * 64) *(LAS f32x4*)(gl + 4 * i) = *(const f32x4*)(gain + 4 * i);
    __syncthreads();
    for (int m = gw; m < M; m += NGW) {
        v4u mv[8]; f32x4 hx[MODE == 0 ? 8 : 1][2]; v4u hq[MODE == 0 ? 1 : 8];
#pragma unroll
        for (int j = 0; j < 8; ++j) { const size_t o = (size_t)m * D + j * 512 + lane * 8; mv[j] = *(const GAS v4u*)(mb + o);
            if (MODE == 0) { hx[j % (MODE == 0 ? 8 : 1)][0] = *(const GAS f32x4*)(xin + o); hx[j % (MODE == 0 ? 8 : 1)][1] = *(const GAS f32x4*)(xin + o + 4); }
            else hq[j % (MODE == 0 ? 1 : 8)] = *(const GAS v4u*)(hb + o); }
        float s = 0.f;
#pragma unroll
        for (int j = 0; j < 8; ++j) { const float a0 = bf_lo(mv[j].x), a1 = bf_hi(mv[j].x), a2 = bf_lo(mv[j].y), a3 = bf_hi(mv[j].y), a4 = bf_lo(mv[j].z), a5 = bf_hi(mv[j].z), a6 = bf_lo(mv[j].w), a7 = bf_hi(mv[j].w);
            s += (a0 * a0 + a1 * a1) + (a2 * a2 + a3 * a3) + (a4 * a4 + a5 * a5) + (a6 * a6 + a7 * a7); }
        s = wave_sum(s);
        const float rm = 1.0f / sqrtf(s * (1.0f / D) + EPS);
        float s2 = 0.f;
#pragma unroll
        for (int j = 0; j < 8; ++j) { const size_t o = (size_t)m * D + j * 512 + lane * 8;
            const f32x4 g0 = *(const LAS f32x4*)(gl + j * 512 + lane * 8), g1 = *(const LAS f32x4*)(gl + j * 512 + lane * 8 + 4);
            const f32x4 m0 = {bf_lo(mv[j].x), bf_hi(mv[j].x), bf_lo(mv[j].y), bf_hi(mv[j].y)}, m1 = {bf_lo(mv[j].z), bf_hi(mv[j].z), bf_lo(mv[j].w), bf_hi(mv[j].w)};
            f32x4 p0, p1;
            if (MODE == 0) { p0 = hx[j % (MODE == 0 ? 8 : 1)][0]; p1 = hx[j % (MODE == 0 ? 8 : 1)][1]; }
            else { const v4u t = hq[j % (MODE == 0 ? 1 : 8)]; p0 = (f32x4){bf_lo(t.x), bf_hi(t.x), bf_lo(t.y), bf_hi(t.y)}; p1 = (f32x4){bf_lo(t.z), bf_hi(t.z), bf_lo(t.w), bf_hi(t.w)}; }
            const f32x4 h0 = p0 + m0 * rm * g0, h1 = p1 + m1 * rm * g1;
            if (MODE == 2) { *(GAS f32x4*)(outp + o) = h0; *(GAS f32x4*)(outp + o + 4) = h1; }
            else { s2 += (h0.x * h0.x + h0.y * h0.y) + (h0.z * h0.z + h0.w * h0.w) + (h1.x * h1.x + h1.y * h1.y) + (h1.z * h1.z + h1.w * h1.w);
                v4u w; w.x = pk2(h0.x, h0.y); w.y = pk2(h0.z, h0.w); w.z = pk2(h1.x, h1.y); w.w = pk2(h1.z, h1.w); *(GAS v4u*)(hb + o) = w; }
        }
        if (MODE != 2) { s2 = wave_sum(s2); if (lane == 0) rs_out[m] = 1.0f / sqrtf(s2 * (1.0f / D) + EPS); }
    }
    __syncthreads();
}

constexpr int AK_ROW = 144, AV_ROW = 528;
constexpr int AK_OFF = 0, AV_OFF = 256 * AK_ROW;
__device__ __forceinline__ void attn_phase(Frame& F) {
    refresh(F);
    const KArgs A_ = kargs();
    const bf16* Q = (const bf16*)(A_->ws + WS_Q); const bf16* Kg = (const bf16*)(A_->ws + WS_K); const bf16* Vg = (const bf16*)(A_->ws + WS_V); bf16* O = (bf16*)(A_->ws + WS_GA);
    const float* sinks = (const float*)A_->in[22];
    LAS unsigned char* Ks = F.lds + RING_OFF + AK_OFF; LAS unsigned char* Vt = F.lds + RING_OFF + AV_OFF;
    const int tid = F.tid, lane = F.lane, col = lane & 31, h = lane >> 5;
    constexpr float SC = 0.125f * 1.4426950408889634f;
    for (int unit = F.vcu; unit < NB * 8 * 32; unit += F.G) {
        const int b = unit >> 8, kvh = (unit >> 5) & 7, qblk = unit & 31;
        const int key0 = 128 * (qblk - 1);
        __syncthreads();
#pragma unroll
        for (int i = 0; i < 4; ++i) { const int t = tid + 512 * i, kr = t >> 3, c = t & 7; const int ks = key0 + kr;
            v4u v = {0u, 0u, 0u, 0u}; if (ks >= 0) v = *(const GAS v4u*)(Kg + (size_t)(b * SEQ + ks) * 512 + kvh * 64 + 8 * c);
            *(LAS v4u*)(Ks + kr * AK_ROW + 16 * c) = v; }
#pragma unroll
        for (int i = 0; i < 2; ++i) { const int t = tid + 512 * i, kp = t & 127, c = t >> 7; const int ka = 2 * kp, ks = key0 + ka;
            v4u va = {0u, 0u, 0u, 0u}, vb = {0u, 0u, 0u, 0u};
            if (ks >= 0) { va = *(const GAS v4u*)(Vg + (size_t)(b * SEQ + ks) * 512 + kvh * 64 + 8 * c); vb = *(const GAS v4u*)(Vg + (size_t)(b * SEQ + ks + 1) * 512 + kvh * 64 + 8 * c); }
            const int kap = ka & 15, pos = (ka & ~15) + 8 * ((kap >> 2) & 1) + 4 * (kap >> 3) + (kap & 3);
            LAS unsigned char* dst = Vt + (8 * c) * AV_ROW + pos * 2;
            *(LAS unsigned*)(dst + 0 * AV_ROW) = (va.x & 0xffffu) | (vb.x << 16); *(LAS unsigned*)(dst + 1 * AV_ROW) = (va.x >> 16) | (vb.x & 0xffff0000u);
            *(LAS unsigned*)(dst + 2 * AV_ROW) = (va.y & 0xffffu) | (vb.y << 16); *(LAS unsigned*)(dst + 3 * AV_ROW) = (va.y >> 16) | (vb.y & 0xffff0000u);
            *(LAS unsigned*)(dst + 4 * AV_ROW) = (va.z & 0xffffu) | (vb.z << 16); *(LAS unsigned*)(dst + 5 * AV_ROW) = (va.z >> 16) | (vb.z & 0xffff0000u);
            *(LAS unsigned*)(dst + 6 * AV_ROW) = (va.w & 0xffffu) | (vb.w << 16); *(LAS unsigned*)(dst + 7 * AV_ROW) = (va.w >> 16) | (vb.w & 0xffff0000u); }
        __syncthreads();
        const int head = kvh * 8 + F.wave;
        const float sink2 = sinks[head] * 1.4426950408889634f;
#pragma unroll 1
        for (int qs = 0; qs < 4; ++qs) {
            const size_t qrow = (size_t)(b * SEQ + 128 * qblk + 32 * qs + col);
            bf16x8 qf[4];
#pragma unroll
            for (int s4 = 0; s4 < 4; ++s4) qf[s4] = *(const GAS bf16x8*)(Q + qrow * D + head * 64 + 16 * s4 + 8 * h);
            f32x16 sc[5];
#pragma unroll
            for (int t = 0; t < 5; ++t) {
#pragma unroll
                for (int r = 0; r < 16; ++r) sc[t][r] = 0.f;
#pragma unroll
                for (int s4 = 0; s4 < 4; ++s4) { const bf16x8 kf = *(const LAS bf16x8*)(Ks + (32 * (qs + t) + col) * AK_ROW + (16 * s4 + 8 * h) * 2);
                    sc[t] = __builtin_amdgcn_mfma_f32_32x32x16_bf16(kf, qf[s4], sc[t], 0, 0, 0); }
            }
            float mloc = -1e30f;
#pragma unroll
            for (int t = 0; t < 5; ++t) { const bool tile_ok = (qblk > 0) || (qs + t >= 4);
#pragma unroll
                for (int r = 0; r < 16; ++r) { const int row = (r & 3) + 8 * (r >> 2) + 4 * h;
                    bool ok = tile_ok; if (t == 0) ok = ok && (row > col); if (t == 4) ok = ok && (row <= col);
                    const float v = ok ? sc[t][r] * SC : -1e30f; sc[t][r] = v; mloc = fmaxf(mloc, v); } }
            float m2 = fmaxf(mloc, __shfl_xor(mloc, 32)); m2 = fmaxf(m2, sink2);
            float lloc = 0.f;
#pragma unroll
            for (int t = 0; t < 5; ++t)
#pragma unroll
                for (int r = 0; r < 16; ++r) { const float p = __builtin_amdgcn_exp2f(sc[t][r] - m2); sc[t][r] = p; lloc += p; }
            const float l = lloc + __shfl_xor(lloc, 32) + __builtin_amdgcn_exp2f(sink2 - m2);
            f32x16 o[2];
#pragma unroll
            for (int r = 0; r < 16; ++r) { o[0][r] = 0.f; o[1][r] = 0.f; }
#pragma unroll
            for (int t = 0; t < 5; ++t)
#pragma unroll
                for (int s2 = 0; s2 < 2; ++s2) {
                    v4u pw; pw.x = pk2(sc[t][8 * s2 + 0], sc[t][8 * s2 + 1]); pw.y = pk2(sc[t][8 * s2 + 2], sc[t][8 * s2 + 3]); pw.z = pk2(sc[t][8 * s2 + 4], sc[t][8 * s2 + 5]); pw.w = pk2(sc[t][8 * s2 + 6], sc[t][8 * s2 + 7]);
                    const bf16x8 pb = __builtin_bit_cast(bf16x8, pw);
#pragma unroll
                    for (int db = 0; db < 2; ++db) { const bf16x8 vf = *(const LAS bf16x8*)(Vt + (32 * db + col) * AV_ROW + (32 * (qs + t) + 16 * s2 + 8 * h) * 2);
                        o[db] = __builtin_amdgcn_mfma_f32_32x32x16_bf16(vf, pb, o[db], 0, 0, 0); }
                }
            const float inv = 1.0f / l;
#pragma unroll
            for (int db = 0; db < 2; ++db)
#pragma unroll
                for (int g4 = 0; g4 < 4; ++g4) { v2u w; w.x = pk2(o[db][4 * g4] * inv, o[db][4 * g4 + 1] * inv); w.y = pk2(o[db][4 * g4 + 2] * inv, o[db][4 * g4 + 3] * inv);
                    *(GAS v2u*)(O + qrow * D + head * 64 + 32 * db + 8 * g4 + 4 * h) = w; }
        }
    }
    __syncthreads();
}

#define GEMM_PHASE(EPI, Aptr, Wptr, NN, KK, ...) do { pg8::Gemm g{(const bf16*)(Aptr), (const bf16*)(Wptr), M, NN, KK}; pg8::StaticOrder S; S.init(M, NN, F.G, (int)blockIdx.x); \
        pg8::EPI E{__VA_ARGS__}; pg8::gemm_phase<pg8::EPI, pg8::StaticOrder, true, true>(F.lds + RING_OFF, g, S, E); } while (0)
__global__ void __launch_bounds__(NWAVES * 64, 2) fwd(Args args_unused) {
    extern __shared__ __attribute__((aligned(16))) unsigned char lds[];
    Frame F;
    F.lds = (LAS unsigned char*)lds;
    F.tid = threadIdx.x; F.lane = F.tid & 63; F.wave = __builtin_amdgcn_readfirstlane(F.tid >> 6);
    F.G = gridDim.x; { const int bx = blockIdx.x; F.vcu = (F.G % 8 == 0) ? (bx % 8) * (F.G / 8) + bx / 8 : bx; }
    for (int u = F.tid; u < (LDS_BYTES - LDSCTL_OFF) / 4; u += NWAVES * 64) ((LAS unsigned*)(F.lds + LDSCTL_OFF))[u] = 0u;
    __syncthreads();
    XcdBarrier bar = xcd_barrier_post((unsigned*)(kargs()->ws + WS_CTL) + CW_BAR, (volatile LAS unsigned*)(F.lds + MISC_OFF) + 8);
#define WSP(off) (kargs()->ws + (off))
#define RSP(i) ((float*)(kargs()->ws + WS_RS) + (size_t)(i) * M)
#define INF(i) ((const float*)kargs()->in[i])

    p0_prologue(F); xcd_barrier(bar);
    s5_phase(F); xcd_barrier(bar);
    GEMM_PHASE(EpiGlu, WSP(WS_GA), WSP(WS_WGLU), NGLU, D, (bf16*)WSP(WS_MB), D, INF(15), INF(17)); xcd_barrier(bar);
    { const KArgs a = kargs(); resid_phase<0>(F, (const bf16*)(a->ws + WS_MB), (const float*)a->in[0], (bf16*)(a->ws + WS_HB), nullptr, (float*)(a->ws + WS_RS) + M, (const float*)a->in[3]); } xcd_barrier(bar);
    GEMM_PHASE(EpiSwiglu, WSP(WS_HB), WSP(WS_WUP0), NUP, D, (bf16*)WSP(WS_ACT), FF, RSP(1)); xcd_barrier(bar);
    GEMM_PHASE(EpiPlain, WSP(WS_ACT), WSP(WS_WDN0), D, FF, (bf16*)WSP(WS_MB), D, nullptr); xcd_barrier(bar);
    { const KArgs a = kargs(); resid_phase<1>(F, (const bf16*)(a->ws + WS_MB), nullptr, (bf16*)(a->ws + WS_HB), nullptr, (float*)(a->ws + WS_RS) + 2 * M, (const float*)a->in[5]); } xcd_barrier(bar);
    GEMM_PHASE(EpiQkv, WSP(WS_HB), WSP(WS_WQKV), NQKV, D, (bf16*)WSP(WS_Q), (bf16*)WSP(WS_K), (bf16*)WSP(WS_V), RSP(2), INF(19), (const int*)kargs()->in[1]); xcd_barrier(bar);
    attn_phase(F); xcd_barrier(bar);
    GEMM_PHASE(EpiPlain, WSP(WS_GA), WSP(WS_WO), D, D, (bf16*)WSP(WS_MB), D, INF(21)); xcd_barrier(bar);
    { const KArgs a = kargs(); resid_phase<1>(F, (const bf16*)(a->ws + WS_MB), nullptr, (bf16*)(a->ws + WS_HB), nullptr, (float*)(a->ws + WS_RS) + 3 * M, (const float*)a->in[3] + D); } xcd_barrier(bar);
    GEMM_PHASE(EpiSwiglu, WSP(WS_HB), WSP(WS_WUP1), NUP, D, (bf16*)WSP(WS_ACT), FF, RSP(3)); xcd_barrier(bar);
    GEMM_PHASE(EpiPlain, WSP(WS_ACT), WSP(WS_WDN1), D, FF, (bf16*)WSP(WS_MB), D, nullptr); xcd_barrier(bar);
    { const KArgs a = kargs(); resid_phase<2>(F, (const bf16*)(a->ws + WS_MB), nullptr, (bf16*)(a->ws + WS_HB), a->out, nullptr, (const float*)a->in[5] + D); }
}

extern "C" void kernel_launch(void* const* d_in, const int* in_sizes, int n_in, void* d_out, int out_size, void* d_ws, size_t ws_size, hipStream_t stream) {
    static int grid = 0;
    if (grid == 0) {
        if (n_in != 26 || in_sizes[0] != M * D || out_size != M * D || ws_size < WS_END) { fprintf(stderr, "kernel_launch: unexpected shapes (n_in %d, in0 %d, out %d, ws %zu); nothing launched\n", n_in, n_in > 0 ? in_sizes[0] : -1, out_size, ws_size); grid = -1; return; }
        int dev = 0, cus = 0, per_cu = 0;
        if (hipGetDevice(&dev) != hipSuccess || hipDeviceGetAttribute(&cus, hipDeviceAttributeMultiprocessorCount, dev) != hipSuccess) { grid = -1; return; }
        if (hipFuncSetAttribute((const void*)fwd, hipFuncAttributeMaxDynamicSharedMemorySize, LDS_BYTES) != hipSuccess) { fprintf(stderr, "kernel_launch: hipFuncSetAttribute failed\n"); grid = -1; return; }
        if (hipOccupancyMaxActiveBlocksPerMultiprocessor(&per_cu, (const void*)fwd, NWAVES * 64, LDS_BYTES) != hipSuccess || per_cu < 1)
            fprintf(stderr, "kernel_launch: note: occupancy query reports %d workgroups per CU\n", per_cu);
        (void)hipGetLastError();
        grid = cus;
    }
    if (grid < 0) return;
    if (hipMemsetAsync((char*)d_ws + WS_CTL, 0, CTL_ZERO_BYTES, stream) != hipSuccess) { fprintf(stderr, "kernel_launch: hipMemsetAsync failed\n"); return; }
    Args a{};
    for (int i = 0; i < 26; ++i) a.in[i] = d_in[i];
    a.out = (float*)d_out; a.ws = (unsigned char*)d_ws;
    hipLaunchKernelGGL(fwd, dim3(grid), dim3(NWAVES * 64), LDS_BYTES, stream, a);
    const hipError_t le = hipPeekAtLastError();
    if (le != hipSuccess) fprintf(stderr, "kernel_launch: launch failed: %s\n", hipGetErrorName(le));
}
```

```cpp
#include <hip/hip_runtime.h>
#include <cstdio>
#include <cstdint>

namespace pg8 {
#define PG8_LAS __attribute__((address_space(3)))
typedef unsigned short bf16_t;
typedef short bf16x8 __attribute__((ext_vector_type(8)));
typedef float f32x4 __attribute__((ext_vector_type(4)));
typedef unsigned u32x4 __attribute__((ext_vector_type(4)));
constexpr int BM = 256, BK = 64, HALF = 128, HTB = HALF * BK * 2, STAGE_BYTES = 8 * HTB, NXCD = 8, WGM = 8;

__host__ __device__ __forceinline__ int lds_byte(int r, int c) { const int st = (r >> 4) * 2 + (c >> 5), rr = r & 15, cc = c & 31, ob = rr * 64 + cc * 2; return st * 1024 + (ob ^ (((ob >> 9) & 1) << 5)); }
__host__ __device__ __forceinline__ void stage_rc(int b, int& R, int& C) { const int st = b / 1024, sb = b % 1024, swz = sb ^ (((sb >> 9) & 1) << 5); R = (st >> 1) * 16 + swz / 64; C = (st & 1) * 32 + (swz % 64) / 2; }
__host__ __device__ __forceinline__ int perm32(int rho) { const int n = rho >> 4, i = rho & 15; return 8 * (i >> 2) + 4 * n + (i & 3); }

struct Unit { int pm, pn; };
struct Gemm { const bf16_t* A; const bf16_t* Bt; int M, N, K; };

struct StaticOrder {
    int nM, nN, nwg, G, c;
    __host__ __device__ void init(int M, int N, int G_, int c_) { nM = M / BM; nN = N / BM; nwg = nM * nN; G = G_; c = c_; }
    __host__ __device__ bool next(int i, Unit& u) const {
        const long L = (long)i * G + c; if (L >= nwg) return false;
        int wgid = (int)L; { const int q = nwg / NXCD, r = nwg % NXCD, xcd = wgid % NXCD, off = wgid / NXCD; wgid = (xcd < r ? xcd * (q + 1) : r * (q + 1) + (xcd - r) * q) + off; }
        const int nig = WGM * nN, gid = wgid / nig, fm = gid * WGM, gsz = (nM - fm) < WGM ? (nM - fm) : WGM;
        u.pm = fm + ((wgid % nig) % gsz); u.pn = (wgid % nig) / gsz; return true;
    }
    __device__ __forceinline__ void a_ready(const Unit&) const {}
    __device__ __forceinline__ void done(const Unit&) const {}
};

__device__ __forceinline__ unsigned cvt_pk_bf16(float lo, float hi) { unsigned r; asm volatile("v_cvt_pk_bf16_f32 %0, %1, %2" : "=v"(r) : "v"(lo), "v"(hi)); return r; }

#ifndef EPI_AUX
#define EPI_AUX 0
#endif
__device__ __forceinline__ void st16(const void* base, unsigned byte_off, u32x4 v) {
    const __amdgpu_buffer_rsrc_t r = __builtin_amdgcn_make_buffer_rsrc((void*)base, (short)0, 0x7fffffff, 0x00020000);
    __builtin_amdgcn_raw_buffer_store_b128(v, r, (int)byte_off, 0, EPI_AUX);
}

struct EpiPlain {
    static constexpr bool PERM = true, AFTER_DRAIN = false; static constexpr int NST = 16;
    bf16_t* O; int ldc; const float* bias;
    __device__ __forceinline__ void operator()(const f32x4 (&acc)[2][2][4][2], const Unit& u, int wr, int wc, int fr, int fq) const {
        const int row0 = u.pm * BM + wr * 64 + fr; const int col0 = u.pn * BM + wc * 32 + 8 * fq;
        f32x4 bv[2][2];
#pragma unroll
        for (int bj = 0; bj < 2; ++bj)
#pragma unroll
            for (int n = 0; n < 2; ++n) bv[bj][n] = bias ? *(const f32x4*)(bias + col0 + bj * HALF + 4 * n) : (f32x4){0.f, 0.f, 0.f, 0.f};
#pragma unroll
        for (int ai = 0; ai < 2; ++ai)
#pragma unroll
            for (int m = 0; m < 4; ++m) { const unsigned rowo = ((unsigned)(row0 + ai * HALF + m * 16) * (unsigned)ldc + (unsigned)col0) * 2u;
#pragma unroll
                for (int bj = 0; bj < 2; ++bj) { const f32x4 v0 = acc[ai][bj][m][0] + bv[bj][0], v1 = acc[ai][bj][m][1] + bv[bj][1];
                    u32x4 w; w.x = cvt_pk_bf16(v0[0], v0[1]); w.y = cvt_pk_bf16(v0[2], v0[3]); w.z = cvt_pk_bf16(v1[0], v1[1]); w.w = cvt_pk_bf16(v1[2], v1[3]);
                    st16(O, rowo + bj * HALF * 2, w); } }
    }
};
__device__ __forceinline__ float sigmoid_f(float x) { return __builtin_amdgcn_rcpf(1.0f + __builtin_amdgcn_exp2f(-1.4426950408889634f * x)); }
struct EpiGlu {
    static constexpr bool PERM = true, AFTER_DRAIN = false; static constexpr int NST = 8;
    bf16_t* O; int ldc; const float* b1; const float* b2;
    __device__ __forceinline__ void operator()(const f32x4 (&acc)[2][2][4][2], const Unit& u, int wr, int wc, int fr, int fq) const {
        const int row0 = u.pm * BM + wr * 64 + fr; const int col0 = u.pn * HALF + wc * 32 + 8 * fq;
        f32x4 bv[2][2];
#pragma unroll
        for (int n = 0; n < 2; ++n) { bv[0][n] = *(const f32x4*)(b1 + col0 + 4 * n); bv[1][n] = *(const f32x4*)(b2 + col0 + 4 * n); }
#pragma unroll
        for (int ai = 0; ai < 2; ++ai)
#pragma unroll
            for (int m = 0; m < 4; ++m) { const unsigned rowo = ((unsigned)(row0 + ai * HALF + m * 16) * (unsigned)ldc + (unsigned)col0) * 2u;
                f32x4 o[2];
#pragma unroll
                for (int n = 0; n < 2; ++n) { const f32x4 a = acc[ai][0][m][n] + bv[0][n], g = acc[ai][1][m][n] + bv[1][n];
#pragma unroll
                    for (int j = 0; j < 4; ++j) o[n][j] = a[j] * sigmoid_f(g[j]); }
                u32x4 w; w.x = cvt_pk_bf16(o[0][0], o[0][1]); w.y = cvt_pk_bf16(o[0][2], o[0][3]); w.z = cvt_pk_bf16(o[1][0], o[1][1]); w.w = cvt_pk_bf16(o[1][2], o[1][3]);
                st16(O, rowo, w); }
    }
};
struct EpiSwiglu {
    static constexpr bool PERM = true, AFTER_DRAIN = false; static constexpr int NST = 8;
    bf16_t* O; int ldc;
    __device__ __forceinline__ void operator()(const f32x4 (&acc)[2][2][4][2], const Unit& u, int wr, int wc, int fr, int fq) const {
        const int row0 = u.pm * BM + wr * 64 + fr; const int col0 = u.pn * HALF + wc * 32 + 8 * fq;
#pragma unroll
        for (int ai = 0; ai < 2; ++ai)
#pragma unroll
            for (int m = 0; m < 4; ++m) { const int row = row0 + ai * HALF + m * 16; const unsigned rowo = ((unsigned)row * (unsigned)ldc + (unsigned)col0) * 2u;
                f32x4 o[2];
#pragma unroll
                for (int n = 0; n < 2; ++n) { const f32x4 g = acc[ai][0][m][n], up = acc[ai][1][m][n];
#pragma unroll
                    for (int j = 0; j < 4; ++j) o[n][j] = g[j] * sigmoid_f(g[j]) * up[j]; }
                u32x4 w; w.x = cvt_pk_bf16(o[0][0], o[0][1]); w.y = cvt_pk_bf16(o[0][2], o[0][3]); w.z = cvt_pk_bf16(o[1][0], o[1][1]); w.w = cvt_pk_bf16(o[1][2], o[1][3]);
                st16(O, rowo, w); }
    }
};
struct EpiQkv {
    static constexpr bool PERM = true, AFTER_DRAIN = false; static constexpr int NST = 16;
    bf16_t* Q; bf16_t* Kb; bf16_t* Vb; const float* bias; const int* pos;
    __device__ __forceinline__ void operator()(const f32x4 (&acc)[2][2][4][2], const Unit& u, int wr, int wc, int fr, int fq) const {
        const int row0 = u.pm * BM + wr * 64 + fr; const int head = 4 * u.pn + wc;
        bf16_t* base; int ld, hcol;
        if (head < 64) { base = Q; ld = 4096; hcol = head * 64; } else if (head < 72) { base = Kb; ld = 512; hcol = (head - 64) * 64; } else { base = Vb; ld = 512; hcol = (head - 72) * 64; }
        const bool rope = head < 72;
        f32x4 bv[2][2];
#pragma unroll
        for (int bj = 0; bj < 2; ++bj)
#pragma unroll
            for (int n = 0; n < 2; ++n) bv[bj][n] = *(const f32x4*)(bias + head * 64 + 32 * bj + 8 * fq + 4 * n);
        float invf[2][4];
#pragma unroll
        for (int n = 0; n < 2; ++n)
#pragma unroll
            for (int j = 0; j < 4; ++j) invf[n][j] = exp2f(-(float)(8 * fq + 4 * n + j) * (13.287712379549449f / 32.0f));
#pragma unroll
        for (int ai = 0; ai < 2; ++ai)
#pragma unroll
            for (int m = 0; m < 4; ++m) { const int row = row0 + ai * HALF + m * 16; const float p = (float)pos[row];
                f32x4 v[2][2];
#pragma unroll
                for (int bj = 0; bj < 2; ++bj)
#pragma unroll
                    for (int n = 0; n < 2; ++n) v[bj][n] = acc[ai][bj][m][n] + bv[bj][n];
                if (rope) {
#pragma unroll
                    for (int n = 0; n < 2; ++n)
#pragma unroll
                        for (int j = 0; j < 4; ++j) { const float ang = p * invf[n][j]; const float t = __builtin_amdgcn_fractf(ang * 0.15915494309189535f);
                            const float sn = __builtin_amdgcn_sinf(t), cs = __builtin_amdgcn_cosf(t); const float x1 = v[0][n][j], x2 = v[1][n][j];
                            v[0][n][j] = x1 * cs - x2 * sn; v[1][n][j] = x2 * cs + x1 * sn; }
                }
                const unsigned rowo = ((unsigned)row * (unsigned)ld + (unsigned)(hcol + 8 * fq)) * 2u;
#pragma unroll
                for (int bj = 0; bj < 2; ++bj) { u32x4 w; w.x = cvt_pk_bf16(v[bj][0][0], v[bj][0][1]); w.y = cvt_pk_bf16(v[bj][0][2], v[bj][0][3]); w.z = cvt_pk_bf16(v[bj][1][0], v[bj][1][1]); w.w = cvt_pk_bf16(v[bj][1][2], v[bj][1][3]);
                    st16(base, rowo + 64 * bj, w); } }
    }
};

template <class Epi, class Sched, bool ALIGN_EPI = false, bool SP2 = false>
__device__ __forceinline__ void gemm_phase(PG8_LAS unsigned char* lds, const Gemm g, const Sched& S, const Epi& E) {
    int tid = threadIdx.x; asm volatile("" : "+v"(tid));
    const int wid = __builtin_amdgcn_readfirstlane(tid >> 6), lane = tid & 63, wr = wid >> 2, wc = wid & 3, fr = lane & 15, fq = lane >> 4;
    const int K = g.K, nt = K / BK;
#ifdef GEMM_STAGGER_TICKS
    { const unsigned long long t0 = __builtin_amdgcn_s_memrealtime(); const unsigned long long dl = (unsigned long long)(((blockIdx.x >> 3) & 3) * GEMM_STAGGER_TICKS);
      while (__builtin_amdgcn_s_memrealtime() - t0 < dl) __builtin_amdgcn_s_sleep(8); }
#endif
    unsigned voffA[2], voffB[2];
#pragma unroll
    for (int i = 0; i < 2; ++i) { int R, C; stage_rc(tid * 16 + i * 8192, R, C); const int Rb = Epi::PERM ? ((R & ~31) + perm32(R & 31)) : R;
        voffA[i] = (unsigned)(R * K + C) * 2u; voffB[i] = (unsigned)(Rb * K + C) * 2u; }
    const size_t kstep = (size_t)(BK * 2);
    const size_t hstep = (size_t)HALF * K * 2;
    const size_t tstep = 2 * hstep;
    const unsigned ldsw = (unsigned)wid * 1024u;
    const int aoff = lds_byte(wr * 64 + fr, fq * 8), boff = lds_byte(wc * 32 + fr, fq * 8);
#define PG8_SA(b, h) (((b) * 2 + (h)) * HTB)
#define PG8_SB(b, h) ((4 + (b) * 2 + (h)) * HTB)
#define PG8_STAGE(bufoff, gbase, voff) do { _Pragma("unroll") for (int _i = 0; _i < 2; ++_i) \
        __builtin_amdgcn_global_load_lds((const unsigned*)((const char*)(gbase) + (voff)[_i]), (PG8_LAS unsigned*)(lds + (bufoff) + ldsw + _i * 8192), 16, 0, 0); } while (0)
#define PG8_LDA(dst, b, h) do { _Pragma("unroll") for (int m = 0; m < 4; ++m) _Pragma("unroll") for (int k = 0; k < 2; ++k) dst[m][k] = *(const PG8_LAS bf16x8*)(lds + PG8_SA(b, h) + aoff + m * 2048 + k * 1024); } while (0)
#define PG8_LDB(dst, b, h) do { _Pragma("unroll") for (int n = 0; n < 2; ++n) _Pragma("unroll") for (int k = 0; k < 2; ++k) dst[n][k] = *(const PG8_LAS bf16x8*)(lds + PG8_SB(b, h) + boff + n * 2048 + k * 1024); } while (0)
#define PG8_MMA(ai, bj, At, Bt) do { __builtin_amdgcn_s_setprio(1); _Pragma("unroll") for (int m = 0; m < 4; ++m) _Pragma("unroll") for (int n = 0; n < 2; ++n) _Pragma("unroll") for (int k = 0; k < 2; ++k) \
        acc[ai][bj][m][n] = __builtin_amdgcn_mfma_f32_16x16x32_bf16(Bt[n][k], At[m][k], acc[ai][bj][m][n], 0, 0, 0); __builtin_amdgcn_s_setprio(0); } while (0)
#define PG8_WAIT_V(n) asm volatile("s_waitcnt vmcnt(" #n ")" ::: "memory")
#define PG8_WAIT_L(n) asm volatile("s_waitcnt lgkmcnt(" #n ")" ::: "memory")
#define PG8_WAIT_VN(N) asm volatile("s_waitcnt vmcnt(%0)" :: "n"(N) : "memory")
#define PG8_BAR __builtin_amdgcn_s_barrier()
#define PG8_SCHED __builtin_amdgcn_sched_barrier(0)
    Unit cur, nxt; int ui = 0;
    if (!S.next(0, cur)) return;
    f32x4 acc[2][2][4][2];
#pragma unroll
    for (int a = 0; a < 2; ++a)
#pragma unroll
        for (int b = 0; b < 2; ++b)
#pragma unroll
            for (int m = 0; m < 4; ++m)
#pragma unroll
                for (int n = 0; n < 2; ++n) acc[a][b][m][n] = (f32x4){0.f, 0.f, 0.f, 0.f};
    bf16x8 At[4][2], B0[2][2], B1[2][2];
    const char* cA = (const char*)g.A + (size_t)cur.pm * tstep; const char* cB = (const char*)g.Bt + (size_t)cur.pn * tstep;
    S.a_ready(cur);
    if constexpr (SP2) {
        PG8_STAGE(PG8_SB(0, 0), cB, voffB); PG8_STAGE(PG8_SB(0, 1), cB + hstep, voffB); PG8_STAGE(PG8_SA(0, 0), cA, voffA); PG8_STAGE(PG8_SA(0, 1), cA + hstep, voffA);
        if (wr == 1) PG8_BAR;
        PG8_WAIT_V(2); PG8_BAR;
        PG8_STAGE(PG8_SB(1, 0), cB + kstep, voffB); PG8_STAGE(PG8_SA(1, 0), cA + kstep, voffA); PG8_STAGE(PG8_SB(1, 1), cB + hstep + kstep, voffB);
        PG8_WAIT_V(6); PG8_BAR;
    } else {
        PG8_STAGE(PG8_SB(0, 0), cB, voffB); PG8_STAGE(PG8_SA(0, 0), cA, voffA); PG8_STAGE(PG8_SB(0, 1), cB + hstep, voffB); PG8_STAGE(PG8_SA(0, 1), cA + hstep, voffA);
        if (wr == 1) PG8_BAR;
        PG8_WAIT_V(4); PG8_BAR;
        PG8_STAGE(PG8_SB(1, 0), cB + kstep, voffB); PG8_STAGE(PG8_SA(1, 0), cA + kstep, voffA); PG8_STAGE(PG8_SB(1, 1), cB + hstep + kstep, voffB);
        PG8_WAIT_V(6); PG8_BAR;
    }
    for (;;) {
        const bool has_next = S.next(ui + 1, nxt);
        const char* nA = has_next ? (const char*)g.A + (size_t)nxt.pm * tstep : cA; const char* nB = has_next ? (const char*)g.Bt + (size_t)nxt.pn * tstep : cB;
        for (int t = 0; t < nt; t += 2) {
            const bool last = (t == nt - 2);
            const char* a1 = cA + (size_t)(t + 1) * kstep;
            const char* a2 = last ? nA : cA + (size_t)(t + 2) * kstep; const char* b2 = last ? nB : cB + (size_t)(t + 2) * kstep;
            const char* a3 = a2 + kstep; const char* b3 = b2 + kstep;
            if (last && has_next) S.a_ready(nxt);
            if constexpr (SP2) {
            PG8_LDB(B0, 0, 0); PG8_LDB(B1, 0, 1); PG8_SCHED; PG8_LDA(At, 0, 0); PG8_STAGE(PG8_SA(1, 1), a1 + hstep, voffA);
            PG8_WAIT_V(8); PG8_WAIT_L(0); PG8_BAR; PG8_MMA(0, 0, At, B0); PG8_MMA(0, 1, At, B1); PG8_BAR; PG8_SCHED;
            PG8_LDA(At, 0, 1); PG8_STAGE(PG8_SB(0, 0), b2, voffB); PG8_STAGE(PG8_SB(0, 1), b2 + hstep, voffB); PG8_STAGE(PG8_SA(0, 0), a2, voffA);
            PG8_WAIT_V(8); PG8_WAIT_L(0); PG8_BAR; PG8_MMA(1, 0, At, B0); PG8_MMA(1, 1, At, B1); PG8_BAR; PG8_SCHED;
            PG8_LDB(B0, 1, 0); PG8_LDB(B1, 1, 1); PG8_SCHED; PG8_LDA(At, 1, 0); PG8_STAGE(PG8_SA(0, 1), a2 + hstep, voffA);
            PG8_WAIT_V(8); PG8_WAIT_L(0); PG8_BAR; PG8_MMA(0, 0, At, B0); PG8_MMA(0, 1, At, B1); PG8_BAR; PG8_SCHED;
            PG8_LDA(At, 1, 1); PG8_STAGE(PG8_SB(1, 0), b3, voffB); PG8_STAGE(PG8_SB(1, 1), b3 + hstep, voffB); PG8_STAGE(PG8_SA(1, 0), a3, voffA);
            PG8_WAIT_V(8); PG8_WAIT_L(0); PG8_BAR; PG8_MMA(1, 0, At, B0); PG8_MMA(1, 1, At, B1); PG8_BAR; PG8_SCHED;
            } else {
            PG8_LDB(B0, 0, 0); PG8_SCHED; PG8_LDA(At, 0, 0); PG8_STAGE(PG8_SA(1, 1), a1 + hstep, voffA);
            PG8_WAIT_L(8); PG8_BAR; PG8_WAIT_L(0); PG8_MMA(0, 0, At, B0); PG8_BAR; PG8_SCHED;
            PG8_LDB(B1, 0, 1); PG8_STAGE(PG8_SB(0, 0), b2, voffB);
            PG8_BAR; PG8_WAIT_L(0); PG8_MMA(0, 1, At, B1); PG8_BAR;
            PG8_LDA(At, 0, 1); PG8_STAGE(PG8_SA(0, 0), a2, voffA);
            PG8_BAR; PG8_WAIT_L(0); PG8_MMA(1, 0, At, B0); PG8_BAR; PG8_SCHED;
            PG8_STAGE(PG8_SB(0, 1), b2 + hstep, voffB);
            PG8_WAIT_V(6); PG8_BAR; PG8_MMA(1, 1, At, B1); PG8_BAR;
            PG8_LDB(B0, 1, 0); PG8_SCHED; PG8_LDA(At, 1, 0); PG8_STAGE(PG8_SA(0, 1), a2 + hstep, voffA);
            PG8_WAIT_L(8); PG8_BAR; PG8_WAIT_L(0); PG8_MMA(0, 0, At, B0); PG8_BAR; PG8_SCHED;
            PG8_LDB(B1, 1, 1); PG8_STAGE(PG8_SB(1, 0), b3, voffB);
            PG8_BAR; PG8_WAIT_L(0); PG8_MMA(0, 1, At, B1); PG8_BAR;
            PG8_LDA(At, 1, 1); PG8_STAGE(PG8_SA(1, 0), a3, voffA);
            PG8_BAR; PG8_WAIT_L(0); PG8_MMA(1, 0, At, B0); PG8_BAR; PG8_SCHED;
            PG8_STAGE(PG8_SB(1, 1), b3 + hstep, voffB);
            PG8_WAIT_V(6); PG8_BAR; PG8_MMA(1, 1, At, B1); PG8_BAR;
            }
        }
        if constexpr (ALIGN_EPI) { if (wr == 0) PG8_BAR; }
        if constexpr (!Epi::AFTER_DRAIN) { E(acc, cur, wr, wc, fr, fq); S.done(cur); }
        if (!has_next) break;
#pragma unroll
        for (int a = 0; a < 2; ++a)
#pragma unroll
            for (int b = 0; b < 2; ++b)
#pragma unroll
                for (int m = 0; m < 4; ++m)
#pragma unroll
                    for (int n = 0; n < 2; ++n) acc[a][b][m][n] = (f32x4){0.f, 0.f, 0.f, 0.f};
        cur = nxt; cA = nA; cB = nB; ++ui;
        if constexpr (ALIGN_EPI) { if (wr == 1) PG8_BAR; }
    }
    PG8_WAIT_V(0);
    if constexpr (!ALIGN_EPI) { if (wr == 0) PG8_BAR; }
    PG8_BAR;
#undef PG8_SA
#undef PG8_SB
#undef PG8_STAGE
#undef PG8_LDA
#undef PG8_LDB
#undef PG8_MMA
#undef PG8_WAIT_V
#undef PG8_WAIT_L
#undef PG8_WAIT_VN
#undef PG8_BAR
#undef PG8_SCHED
}
}

constexpr int NWAVES = 8;
constexpr int D = 4096, NB = 4, SEQ = 4096, M = NB * SEQ, FF = 11008;
constexpr int NGLU = 2 * D, NUP = 2 * FF, NQKV = 5120;
constexpr int S5G = 256, S5P = 64, S5C = 16;
constexpr float EPS = 1e-6f;

constexpr size_t MiB = 1u << 20;
constexpr size_t WS_CTL = 0, CTL_ZERO_BYTES = 1 * MiB;
constexpr size_t WS_RS = 1 * MiB;
constexpr size_t WS_WGLU = 2 * MiB, WS_WUP0 = 66 * MiB, WS_WDN0 = 238 * MiB, WS_WQKV = 324 * MiB, WS_WO = 364 * MiB, WS_WUP1 = 396 * MiB, WS_WDN1 = 568 * MiB;
constexpr size_t WS_HB = 654 * MiB, WS_GA = 782 * MiB, WS_MB = 910 * MiB, WS_ACT = 1038 * MiB, WS_END = 1382 * MiB;
constexpr size_t WS_Q = WS_ACT, WS_K = WS_ACT + 128 * MiB, WS_V = WS_ACT + 144 * MiB;
constexpr int CW_BAR = 4096;

constexpr int RING_OFF = 0, RING_BYTES = 131072;
constexpr int LDSCTL_OFF = RING_BYTES, MISC_OFF = LDSCTL_OFF + 320;
constexpr int LDS_BYTES = 147456;

#define GAS __attribute__((address_space(1)))
#define LAS __attribute__((address_space(3)))
typedef unsigned short bf16;
typedef unsigned v4u __attribute__((ext_vector_type(4)));
typedef unsigned v2u __attribute__((ext_vector_type(2)));
typedef float f32x4 __attribute__((ext_vector_type(4)));
typedef float f32x16 __attribute__((ext_vector_type(16)));
typedef short bf16x8 __attribute__((ext_vector_type(8)));
using bf16x2 = __attribute__((ext_vector_type(2))) __bf16;
typedef GAS unsigned gu32;
#define LDS_WAIT() asm volatile("s_waitcnt lgkmcnt(0)" ::: "memory")
#define VM_WAIT() asm volatile("s_waitcnt vmcnt(0)" ::: "memory")
__device__ __forceinline__ unsigned pk2(float lo, float hi) { return pg8::cvt_pk_bf16(lo, hi); }
__device__ __forceinline__ float bf_lo(unsigned w) { return __uint_as_float(w << 16); }
__device__ __forceinline__ float bf_hi(unsigned w) { return __uint_as_float(w & 0xffff0000u); }

#define XB_TMO      128
#define XB_XCNT(j)  (256  + 64 * (j))
#define XB_XSUB(j)  (1280 + 64 * (j))
#define XB_XGEN(j)  (2304 + 64 * (j))
#define XB_TOP      3328
#define XB_TOPGEN   3392
#define XCD_BAR_WORDS 3456
#define XB_SPIN_CAP (1u << 18)

__device__ __forceinline__ unsigned xb_ld(unsigned* p)              { return __hip_atomic_load(p, __ATOMIC_RELAXED, __HIP_MEMORY_SCOPE_AGENT); }
__device__ __forceinline__ unsigned xb_add(unsigned* p, unsigned v) { return __hip_atomic_fetch_add(p, v, __ATOMIC_RELAXED, __HIP_MEMORY_SCOPE_AGENT); }
__device__ __forceinline__ unsigned xb_xcc_id() { return (unsigned)__builtin_amdgcn_s_getreg((3 << 11) | 20) & 0xFu; }
#define XB_SPIN(cond, bar) do { unsigned _sp = 0; while (cond) { __builtin_amdgcn_s_sleep(1); \
    if ((++_sp & 255u) == 0u) { if (xb_ld(&(bar)[XB_TMO])) break; if (_sp > XB_SPIN_CAP) { atomicAdd(&(bar)[XB_TMO], 1u); break; } } } } while (0)

struct XcdBarrier {
    unsigned* bar; unsigned x;
    volatile LAS unsigned* st;
};
__device__ __forceinline__ XcdBarrier xcd_barrier_post(unsigned* bar, volatile LAS unsigned* st) {
    XcdBarrier b; b.bar = bar; b.x = xb_xcc_id(); b.st = st;
    if (threadIdx.x == 0) (void)xb_add(&bar[XB_XCNT(b.x)], 1u);
    return b;
}
__device__ __forceinline__ void xcd_barrier_complete(unsigned* bar, unsigned x, unsigned& nloc, unsigned& nx) {
    const unsigned G = gridDim.x * gridDim.y * gridDim.z;
    unsigned sum, cnt, mine, sp = 0u;
    for (;;) {
        sum = 0u; cnt = 0u; mine = 0u;
#pragma unroll
        for (unsigned j = 0; j < 16; ++j) { const unsigned c = xb_ld(&bar[XB_XCNT(j)]); sum += c; cnt += (c > 0u) ? 1u : 0u; mine = (j == x) ? c : mine; }
        if (sum == G) break;
        __builtin_amdgcn_s_sleep(1);
        if ((++sp & 255u) == 0u) { if (xb_ld(&bar[XB_TMO])) break; if (sp > XB_SPIN_CAP) { atomicAdd(&bar[XB_TMO], 1u); break; } }
    }
    nloc = mine > 0u ? mine : 1u; nx = cnt > 0u ? cnt : 1u;
}
__device__ __forceinline__ void xcd_barrier(const XcdBarrier& b) {
    asm volatile("s_waitcnt vmcnt(0)" ::: "memory");
    __syncthreads();
    if (threadIdx.x == 0) {
        unsigned* bar = b.bar;
        __builtin_amdgcn_s_waitcnt(0);
        unsigned nloc = b.st[0], nx = b.st[1];
        if (nloc == 0u) { xcd_barrier_complete(bar, b.x, nloc, nx); b.st[0] = nloc; b.st[1] = nx; }
        const unsigned old = xb_add(&bar[XB_XSUB(b.x)], 1u);
        const unsigned gen = old / nloc;
        if (old + 1u == (gen + 1u) * nloc) {
            __builtin_amdgcn_fence(__ATOMIC_RELEASE, "agent");
            asm volatile("s_waitcnt vmcnt(0)" ::: "memory");
            const unsigned og = xb_add(&bar[XB_TOP], 1u);
            const unsigned tg = og / nx;
            if (og + 1u == (tg + 1u) * nx) xb_add(&bar[XB_TOPGEN], 1u);
            else XB_SPIN(xb_ld(&bar[XB_TOPGEN]) == tg, bar);
            __builtin_amdgcn_fence(__ATOMIC_ACQUIRE, "agent");
            xb_add(&bar[XB_XGEN(b.x)], 1u);
            asm volatile("s_waitcnt vmcnt(0)" ::: "memory");
        } else {
            XB_SPIN(xb_ld(&bar[XB_XGEN(b.x)]) == gen, bar);
            __builtin_amdgcn_fence(__ATOMIC_ACQUIRE, "agent");
            asm volatile("s_waitcnt vmcnt(0)" ::: "memory");
        }
    }
    __syncthreads();
}

struct Frame {
    LAS unsigned char* lds;
    int tid, lane, wave;
    int vcu, G;
};
__device__ __forceinline__ void refresh(Frame& F) { int t = threadIdx.x; asm volatile("" : "+v"(t)); F.tid = t; F.lane = t & 63; F.wave = __builtin_amdgcn_readfirstlane(t >> 6); }
__device__ __forceinline__ float wave_sum(float v) {
#pragma unroll
    for (int o = 1; o < 64; o <<= 1) v += __shfl_xor(v, o);
    return v;
}

struct P0Job { const float* W; bf16* WT; const float* gain; int K, N, drow0, dstep, k0, n0; };
__device__ __forceinline__ void p0_load(const P0Job& J, f32x4 (&a)[8], f32x4 (&b)[8], int lane) {
    const int ksub = lane >> 4, n4 = (lane & 15) * 4;
    const float* wp = J.W + (size_t)(J.k0 + 2 * ksub) * J.N + J.n0 + n4;
#pragma unroll
    for (int i = 0; i < 8; ++i) { a[i] = *(const GAS f32x4*)(wp + (size_t)(8 * i) * J.N); b[i] = *(const GAS f32x4*)(wp + (size_t)(8 * i + 1) * J.N); }
}
__device__ __forceinline__ void p0_to_lds(const P0Job& J, f32x4 (&a)[8], f32x4 (&b)[8], LAS unsigned char* scr, int lane) {
    const int ksub = lane >> 4, n4 = (lane & 15) * 4;
    if (J.gain) {
#pragma unroll
        for (int i = 0; i < 8; ++i) { const float ga = J.gain[J.k0 + 8 * i + 2 * ksub], gb = J.gain[J.k0 + 8 * i + 2 * ksub + 1]; a[i] = a[i] * ga; b[i] = b[i] * gb; }
    }
#pragma unroll
    for (int i = 0; i < 8; ++i)
#pragma unroll
        for (int e = 0; e < 4; ++e) { const int n = n4 + e; *(LAS unsigned*)(scr + n * 128 + (((4 * i + ksub) ^ (2 * (n >> 2))) << 2)) = pk2(a[i][e], b[i][e]); }
    LDS_WAIT(); asm volatile("" ::: "memory");
}
__device__ __forceinline__ void p0_store(const P0Job& J, LAS unsigned char* scr, int lane) {
    const int c = lane & 7;
#pragma unroll
    for (int j = 0; j < 8; ++j) { const int n = (lane >> 3) + 8 * j;
        v4u v = *(const LAS v4u*)(scr + n * 128 + ((c ^ (n >> 3)) << 4));
        if ((n >> 2) & 1) { const unsigned t0 = v.x, t1 = v.y; v.x = v.z; v.y = v.w; v.z = t0; v.w = t1; }
        *(GAS v4u*)(J.WT + (size_t)(J.drow0 + (n & 31) + J.dstep * (n >> 5)) * J.K + J.k0 + 8 * c) = v; }
    LDS_WAIT(); asm volatile("" ::: "memory");
}
__device__ __forceinline__ int map_pair(int n0, int bj) { return 256 * (n0 >> 7) + 128 * bj + (n0 & 127); }
__device__ __forceinline__ int map_qkv(int n0) { const int head = n0 >> 6; return 256 * (head >> 2) + 32 * (head & 3); }

struct Args { const void* in[26]; float* out; unsigned char* ws; };
typedef const __attribute__((address_space(4))) Args* KArgs;
__device__ __forceinline__ KArgs kargs() { KArgs p = (KArgs)__builtin_amdgcn_kernarg_segment_ptr(); asm volatile("" : "+s"(p)); return p; }

__device__ __forceinline__ void p0_prologue(Frame& F) {
    refresh(F);
    const KArgs A_ = kargs();
    LAS unsigned char* scr = F.lds + RING_OFF + F.wave * 16384;
    const int gw = F.vcu * NWAVES + F.wave, NGW = F.G * NWAVES;
    unsigned char* ws = A_->ws;
    constexpr int I_SQ = (D / 64) * (D / 64);
    constexpr int I_UP = (D / 64) * (FF / 64);
    constexpr int I_QKV = (D / 64) * (NQKV / 64);
    constexpr int NITEMS = 2 * I_SQ + 2 * (2 * I_UP) + I_QKV + I_SQ;
    const float* npm = (const float*)A_->in[2];
    const float* npf = (const float*)A_->in[4];
    auto decode = [&](int it, P0Job& J) {
        int r = it;
        if (r < 2 * I_SQ) { const int bj = r >= I_SQ; r -= bj * I_SQ; const int nkb = D / 64, kb = r % nkb, nb = r / nkb;
            J = P0Job{(const float*)A_->in[bj ? 16 : 14], (bf16*)(ws + WS_WGLU), nullptr, D, D, map_pair(64 * nb, bj), 32, 64 * kb, 64 * nb}; return; }
        r -= 2 * I_SQ;
#pragma unroll
        for (int l = 0; l < 2; ++l) {
            if (r < 2 * I_UP) { const int bj = r >= I_UP; r -= bj * I_UP; const int nkb = D / 64, kb = r % nkb, nb = r / nkb;
                J = P0Job{(const float*)A_->in[bj ? 24 : 23] + (size_t)l * D * FF, (bf16*)(ws + (l ? WS_WUP1 : WS_WUP0)), npf + l * D, D, FF, map_pair(64 * nb, bj), 32, 64 * kb, 64 * nb}; return; }
            r -= 2 * I_UP;
        }
        if (r < I_QKV) { const int nkb = D / 64, kb = r % nkb, nb = r / nkb;
            J = P0Job{(const float*)A_->in[18], (bf16*)(ws + WS_WQKV), npm + D, D, NQKV, map_qkv(64 * nb), 128, 64 * kb, 64 * nb}; return; }
        r -= I_QKV;
        { const int nkb = D / 64, kb = r % nkb, nb = r / nkb;
            J = P0Job{(const float*)A_->in[20], (bf16*)(ws + WS_WO), nullptr, D, D, 64 * nb, 32, 64 * kb, 64 * nb}; }
    };
    {
        f32x4 a[8], b[8]; P0Job J, Jn;
        int it = gw;
        if (it < NITEMS) { decode(it, J); p0_load(J, a, b, F.lane); }
        while (it < NITEMS) {
            p0_to_lds(J, a, b, scr, F.lane);
            const int itn = it + NGW;
            if (itn < NITEMS) { decode(itn, Jn); p0_load(Jn, a, b, F.lane); }
            p0_store(J, scr, F.lane);
            J = Jn; it = itn;
        }
    }
    const float* x = (const float*)A_->in[0]; float* rs0 = (float*)(ws + WS_RS);
    for (int m = gw; m < M; m += NGW) {
        const GAS f32x4* xr = (const GAS f32x4*)(x + (size_t)m * D) + F.lane; float s = 0.f;
#pragma unroll
        for (int j = 0; j < 16; ++j) { const f32x4 v = xr[64 * j]; s += (v.x * v.x + v.y * v.y) + (v.z * v.z + v.w * v.w); }
        s = wave_sum(s);
        if (F.lane == 0) rs0[m] = 1.0f / sqrtf(s * (1.0f / D) + EPS);
    }
}

__device__ __forceinline__ void p0_dn_tail(Frame& F, int layer, int rank, int nranks) {
    refresh(F);
    const KArgs A_ = kargs();
    LAS unsigned char* scr = F.lds + RING_OFF + F.wave * 16384;
    const float* W = (const float*)A_->in[25] + (size_t)layer * FF * D;
    bf16* WT = (bf16*)(A_->ws + (layer ? WS_WDN1 : WS_WDN0));
    constexpr int I_DN = (FF / 64) * (D / 64), NKB = FF / 64;
    const int NGW = nranks * NWAVES;
    f32x4 a[8], b[8]; P0Job J, Jn;
    int it = rank * NWAVES + F.wave;
    if (it < I_DN) { J = P0Job{W, WT, nullptr, FF, D, 64 * (it / NKB), 32, 64 * (it % NKB), 64 * (it / NKB)}; p0_load(J, a, b, F.lane); }
    while (it < I_DN) {
        p0_to_lds(J, a, b, scr, F.lane);
        const int itn = it + NGW;
        if (itn < I_DN) { Jn = P0Job{W, WT, nullptr, FF, D, 64 * (itn / NKB), 32, 64 * (itn % NKB), 64 * (itn / NKB)}; p0_load(Jn, a, b, F.lane); }
        p0_store(J, scr, F.lane);
        J = Jn; it = itn;
    }
}

__device__ __forceinline__ bf16x8 pack8(const f32x4 a, const f32x4 b) {
    v4u w; w.x = pk2(a.x, a.y); w.y = pk2(a.z, a.w); w.z = pk2(b.x, b.y); w.w = pk2(b.z, b.w); return __builtin_bit_cast(bf16x8, w);
}
__device__ __forceinline__ float gelu_tanh(float y) {
    const float z = 0.7978845608028654f * (y + 0.044715f * y * y * y);
    return y * __builtin_amdgcn_rcpf(1.0f + __builtin_amdgcn_exp2f(-2.0f * 1.4426950408889634f * z));
}
template <bool FULL>
__device__ __forceinline__ void s5_run(const float* __restrict__ x, const float* __restrict__ rs0, bf16* __restrict__ G, LAS float* U, LAS unsigned char* Sim, int g, int bp, int t0, int nt, int lane,
                                       const bf16x8 (&Bf)[4], const bf16x8 (&Cf)[4], const float (&lr)[2], const float (&li)[2], f32x4 d4, f32x4 gq, float (&sr)[2], float (&si)[2]) {
    const int n = lane & 31, h = lane >> 5, cc = lane & 15, kq = lane >> 4;
    f32x4 xv[4]; float rv[4];
#define S5_ISSUE(L0) do { _Pragma("unroll") for (int i = 0; i < 4; ++i) { const int row = i * 16 + (lane >> 2); const int grow = (2 * bp + (row >> 5)) * SEQ + (L0) + (row & 31); \
        xv[i] = *(const f32x4*)(x + (size_t)grow * D + g * S5C + 4 * (lane & 3)); rv[i] = rs0[grow]; } } while (0)
    S5_ISSUE(t0);
    for (int L0 = t0; L0 < t0 + nt; L0 += 32) {
#pragma unroll
        for (int i = 0; i < 4; ++i) { const int row = i * 16 + (lane >> 2); *(LAS f32x4*)(U + row * 20 + 4 * (lane & 3)) = xv[i] * rv[i] * gq; }
        if (L0 + 32 < t0 + nt) S5_ISSUE(L0 + 32);
#pragma unroll 1
        for (int st = 0; st < 2; ++st) {
            const LAS float* up = U + (((n >> 2) & 1) * 32 + 16 * st + (n & 3) + 4 * (n >> 3)) * 20 + 8 * h;
            const bf16x8 Af = pack8(*(const LAS f32x4*)up, *(const LAS f32x4*)(up + 4));
            f32x16 acc[4];
#pragma unroll
            for (int nb = 0; nb < 4; ++nb) { f32x16 z;
#pragma unroll
                for (int r = 0; r < 16; ++r) z[r] = 0.f;
                acc[nb] = __builtin_amdgcn_mfma_f32_32x32x16_bf16(Af, Bf[nb], z, 0, 0, 0); }
#pragma unroll
            for (int r = 0; r < 16; ++r)
#pragma unroll
                for (int q = 0; q < 2; ++q) {
                    const float nr = fmaf(lr[q], sr[q], fmaf(-li[q], si[q], acc[2 * q][r]));
                    const float ni = fmaf(lr[q], si[q], fmaf(li[q], sr[q], acc[2 * q + 1][r]));
                    sr[q] = nr; si[q] = ni;
                    if (FULL) *(LAS unsigned*)(Sim + (16 * h + r) * 288 + 4 * (n + 32 * q)) = pk2(nr, ni);
                }
            if (FULL) {
#pragma unroll
                for (int hb = 0; hb < 2; ++hb) {
                    f32x4 y = {0.f, 0.f, 0.f, 0.f};
#pragma unroll
                    for (int ks = 0; ks < 4; ++ks) { const bf16x8 sb = *(const LAS bf16x8*)(Sim + (16 * hb + cc) * 288 + (32 * ks + 8 * kq) * 2);
                        y = __builtin_amdgcn_mfma_f32_16x16x32_bf16(Cf[ks], sb, y, 0, 0, 0); }
                    const f32x4 u4 = *(const LAS f32x4*)(U + (hb * 32 + 16 * st + cc) * 20 + 4 * kq);
                    const f32x4 v = y + d4 * u4;
                    v2u w; w.x = pk2(gelu_tanh(v.x), gelu_tanh(v.y)); w.y = pk2(gelu_tanh(v.z), gelu_tanh(v.w));
                    *(GAS v2u*)(G + (size_t)((2 * bp + hb) * SEQ + L0 + 16 * st + cc) * D + g * S5C + 4 * kq) = w;
                }
            }
        }
    }
#undef S5_ISSUE
}
__device__ __forceinline__ void s5_phase(Frame& F) {
    refresh(F);
    const KArgs A_ = kargs();
    const float* x = (const float*)A_->in[0]; const float* rs0 = (const float*)(A_->ws + WS_RS); const float* gain = (const float*)A_->in[2];
    const float* lam_re = (const float*)A_->in[6]; const float* lam_im = (const float*)A_->in[7]; const float* log_step = (const float*)A_->in[8];
    const float* b_re = (const float*)A_->in[9]; const float* b_im = (const float*)A_->in[10]; const float* c_re = (const float*)A_->in[11]; const float* c_im = (const float*)A_->in[12];
    const float* dsk = (const float*)A_->in[13]; bf16* G = (bf16*)(A_->ws + WS_GA);
    const int lane = F.lane, w = F.wave, bp = w >> 2, seg = w & 3;
    constexpr int SEGT = SEQ / 4;
    LAS unsigned char* wl = F.lds + RING_OFF + w * 14336;
    LAS float* U = (LAS float*)wl;
    LAS unsigned char* Sim = wl + 5120;
    LAS float* E = (LAS float*)(F.lds + RING_OFF + 8 * 14336);
    const int n = lane & 31, h = lane >> 5, cc = lane & 15, kq = lane >> 4;
    for (int g = F.vcu; g < S5G; g += F.G) {
        const float stp = expf(log_step[g]);
        float lr[2], li[2], Lr[2], Li[2]; bf16x8 Bf[4];
#pragma unroll
        for (int q = 0; q < 2; ++q) { const int p = n + 32 * q;
            const float are = lam_re[g * S5P + p], aim = lam_im[g * S5P + p];
            const float zr = are * stp, zi = aim * stp;
            const float e = expf(zr); float sn, cs; sincosf(zi, &sn, &cs);
            lr[q] = e * cs; li[q] = e * sn;
            const float e2 = expf(zr * (float)SEGT); float sn2, cs2; sincosf(zi * (float)SEGT, &sn2, &cs2);
            Lr[q] = e2 * cs2; Li[q] = e2 * sn2;
            const float nr = lr[q] - 1.0f, ni = li[q], den = 1.0f / (are * are + aim * aim);
            const float cr = (nr * are + ni * aim) * den, ci = (ni * are - nr * aim) * den;
            const float* brp = b_re + ((size_t)(g * S5P + p) * S5C + 8 * h); const float* bip = b_im + ((size_t)(g * S5P + p) * S5C + 8 * h);
            const f32x4 br0 = *(const f32x4*)brp, br1 = *(const f32x4*)(brp + 4), bi0 = *(const f32x4*)bip, bi1 = *(const f32x4*)(bip + 4);
            Bf[2 * q] = pack8(cr * br0 - ci * bi0, cr * br1 - ci * bi1);
            Bf[2 * q + 1] = pack8(cr * bi0 + ci * br0, cr * bi1 + ci * br1); }
        bf16x8 Cf[4];
#pragma unroll
        for (int ks = 0; ks < 4; ++ks) { const size_t o = (size_t)(g * S5C + cc) * S5P + 16 * ks + 4 * kq;
            const f32x4 cr4 = *(const f32x4*)(c_re + o), ci4 = *(const f32x4*)(c_im + o);
            v4u wv; wv.x = pk2(cr4.x, -ci4.x); wv.y = pk2(cr4.y, -ci4.y); wv.z = pk2(cr4.z, -ci4.z); wv.w = pk2(cr4.w, -ci4.w); Cf[ks] = __builtin_bit_cast(bf16x8, wv); }
        const f32x4 d4 = *(const f32x4*)(dsk + g * S5C + 4 * kq);
        const f32x4 gq = *(const f32x4*)(gain + g * S5C + 4 * (lane & 3));
        float sr[2] = {0.f, 0.f}, si[2] = {0.f, 0.f};
        if (seg < 3) s5_run<false>(x, rs0, G, U, Sim, g, bp, seg * SEGT, SEGT, lane, Bf, Cf, lr, li, d4, gq, sr, si);
#pragma unroll
        for (int q = 0; q < 2; ++q) { E[((w * 2 + q) * 2 + 0) * 64 + lane] = sr[q]; E[((w * 2 + q) * 2 + 1) * 64 + lane] = si[q]; }
        __syncthreads();
        sr[0] = sr[1] = si[0] = si[1] = 0.f;
        for (int j = 0; j < seg; ++j) {
#pragma unroll
            for (int q = 0; q < 2; ++q) { const float er = E[(((bp * 4 + j) * 2 + q) * 2 + 0) * 64 + lane], ei = E[(((bp * 4 + j) * 2 + q) * 2 + 1) * 64 + lane];
                const float nr = Lr[q] * sr[q] - Li[q] * si[q] + er, ni = Lr[q] * si[q] + Li[q] * sr[q] + ei; sr[q] = nr; si[q] = ni; }
        }
        s5_run<true>(x, rs0, G, U, Sim, g, bp, seg * SEGT, SEGT, lane, Bf, Cf, lr, li, d4, gq, sr, si);
        __syncthreads();
    }
}

template <int MODE>
__device__ __forceinline__ void resid_phase(Frame& F, const bf16* __restrict__ mb, const float* __restrict__ xin, bf16* hb, float* __restrict__ outp, float* rms, const float* __restrict__ gain) {
    refresh(F);
    const int gw = F.vcu * NWAVES + F.wave, NGW = F.G * NWAVES, lane = F.lane;
    LAS float* gl = (LAS float*)(F.lds + RING_OFF);
    for (int i = F.tid; i < D / 4; i += NWAVES * 64) *(LAS f32x4*)(gl + 4 * i) = *(const f32x4*)(gain + 4 * i);
    __syncthreads();
    for (int m = gw; m < M; m += NGW) {
        v4u mv[8]; f32x4 hx[MODE == 0 ? 8 : 1][2]; v4u hq[MODE == 0 ? 1 : 8];
        const float rp = (MODE == 0) ? 1.0f : rms[m];
#pragma unroll
        for (int j = 0; j < 8; ++j) { const size_t o = (size_t)m * D + j * 512 + lane * 8; mv[j] = *(const GAS v4u*)(mb + o);
            if (MODE == 0) { hx[j % (MODE == 0 ? 8 : 1)][0] = *(const GAS f32x4*)(xin + o); hx[j % (MODE == 0 ? 8 : 1)][1] = *(const GAS f32x4*)(xin + o + 4); }
            else hq[j % (MODE == 0 ? 1 : 8)] = *(const GAS v4u*)(hb + o); }
        float s = 0.f;
#pragma unroll
        for (int j = 0; j < 8; ++j) { const float a0 = bf_lo(mv[j].x), a1 = bf_hi(mv[j].x), a2 = bf_lo(mv[j].y), a3 = bf_hi(mv[j].y), a4 = bf_lo(mv[j].z), a5 = bf_hi(mv[j].z), a6 = bf_lo(mv[j].w), a7 = bf_hi(mv[j].w);
            s += (a0 * a0 + a1 * a1) + (a2 * a2 + a3 * a3) + (a4 * a4 + a5 * a5) + (a6 * a6 + a7 * a7); }
        s = wave_sum(s);
        const float rm = 1.0f / sqrtf(s * (1.0f / D) + EPS);
        float s2 = 0.f;
        f32x4 hn[MODE == 2 ? 1 : 8][2];
#pragma unroll
        for (int j = 0; j < 8; ++j) { const size_t o = (size_t)m * D + j * 512 + lane * 8;
            const f32x4 g0 = *(const LAS f32x4*)(gl + j * 512 + lane * 8), g1 = *(const LAS f32x4*)(gl + j * 512 + lane * 8 + 4);
            const f32x4 m0 = {bf_lo(mv[j].x), bf_hi(mv[j].x), bf_lo(mv[j].y), bf_hi(mv[j].y)}, m1 = {bf_lo(mv[j].z), bf_hi(mv[j].z), bf_lo(mv[j].w), bf_hi(mv[j].w)};
            f32x4 p0, p1;
            if (MODE == 0) { p0 = hx[j % (MODE == 0 ? 8 : 1)][0]; p1 = hx[j % (MODE == 0 ? 8 : 1)][1]; }
            else { const v4u t = hq[j % (MODE == 0 ? 1 : 8)]; p0 = (f32x4){bf_lo(t.x), bf_hi(t.x), bf_lo(t.y), bf_hi(t.y)} * rp; p1 = (f32x4){bf_lo(t.z), bf_hi(t.z), bf_lo(t.w), bf_hi(t.w)} * rp; }
            const f32x4 h0 = p0 + m0 * rm * g0, h1 = p1 + m1 * rm * g1;
            if (MODE == 2) { *(GAS f32x4*)(outp + o) = h0; *(GAS f32x4*)(outp + o + 4) = h1; }
            else { s2 += (h0.x * h0.x + h0.y * h0.y) + (h0.z * h0.z + h0.w * h0.w) + (h1.x * h1.x + h1.y * h1.y) + (h1.z * h1.z + h1.w * h1.w);
                hn[j % (MODE == 2 ? 1 : 8)][0] = h0; hn[j % (MODE == 2 ? 1 : 8)][1] = h1; }
        }
        if (MODE != 2) { s2 = wave_sum(s2); const float ms = s2 * (1.0f / D) + EPS; const float rh = 1.0f / sqrtf(ms);
            if (lane == 0) rms[m] = sqrtf(ms);
#pragma unroll
            for (int j = 0; j < 8; ++j) { const size_t o = (size_t)m * D + j * 512 + lane * 8; const f32x4 h0 = hn[j % (MODE == 2 ? 1 : 8)][0] * rh, h1 = hn[j % (MODE == 2 ? 1 : 8)][1] * rh;
                v4u w; w.x = pk2(h0.x, h0.y); w.y = pk2(h0.z, h0.w); w.z = pk2(h1.x, h1.y); w.w = pk2(h1.z, h1.w); *(GAS v4u*)(hb + o) = w; } }
    }
    __syncthreads();
}

constexpr int AK_ROW = 144, AV_ROW = 528;
constexpr int AK_OFF = 0, AV_OFF = 256 * AK_ROW;
__device__ __forceinline__ void attn_phase(Frame& F) {
    refresh(F);
    const KArgs A_ = kargs();
    const bf16* Q = (const bf16*)(A_->ws + WS_Q); const bf16* Kg = (const bf16*)(A_->ws + WS_K); const bf16* Vg = (const bf16*)(A_->ws + WS_V); bf16* O = (bf16*)(A_->ws + WS_GA);
    const float* sinks = (const float*)A_->in[22];
    LAS unsigned char* Ks = F.lds + RING_OFF + AK_OFF; LAS unsigned char* Vt = F.lds + RING_OFF + AV_OFF;
    const int tid = F.tid, lane = F.lane, col = lane & 31, h = lane >> 5;
    constexpr float SC = 0.125f * 1.4426950408889634f;
    for (int unit = F.vcu; unit < NB * 8 * 32; unit += F.G) {
        const int b = unit >> 8, kvh = (unit >> 5) & 7, qblk = unit & 31;
        const int key0 = 128 * (qblk - 1);
        __syncthreads();
#pragma unroll
        for (int i = 0; i < 4; ++i) { const int t = tid + 512 * i, kr = t >> 3, c = t & 7; const int ks = key0 + kr;
            v4u v = {0u, 0u, 0u, 0u}; if (ks >= 0) v = *(const GAS v4u*)(Kg + (size_t)(b * SEQ + ks) * 512 + kvh * 64 + 8 * c);
            *(LAS v4u*)(Ks + kr * AK_ROW + 16 * c) = v; }
#pragma unroll
        for (int i = 0; i < 2; ++i) { const int t = tid + 512 * i, kp = t & 127, c = t >> 7; const int ka = 2 * kp, ks = key0 + ka;
            v4u va = {0u, 0u, 0u, 0u}, vb = {0u, 0u, 0u, 0u};
            if (ks >= 0) { va = *(const GAS v4u*)(Vg + (size_t)(b * SEQ + ks) * 512 + kvh * 64 + 8 * c); vb = *(const GAS v4u*)(Vg + (size_t)(b * SEQ + ks + 1) * 512 + kvh * 64 + 8 * c); }
            const int kap = ka & 15, pos = (ka & ~15) + 8 * ((kap >> 2) & 1) + 4 * (kap >> 3) + (kap & 3);
            LAS unsigned char* dst = Vt + (8 * c) * AV_ROW + pos * 2;
            *(LAS unsigned*)(dst + 0 * AV_ROW) = (va.x & 0xffffu) | (vb.x << 16); *(LAS unsigned*)(dst + 1 * AV_ROW) = (va.x >> 16) | (vb.x & 0xffff0000u);
            *(LAS unsigned*)(dst + 2 * AV_ROW) = (va.y & 0xffffu) | (vb.y << 16); *(LAS unsigned*)(dst + 3 * AV_ROW) = (va.y >> 16) | (vb.y & 0xffff0000u);
            *(LAS unsigned*)(dst + 4 * AV_ROW) = (va.z & 0xffffu) | (vb.z << 16); *(LAS unsigned*)(dst + 5 * AV_ROW) = (va.z >> 16) | (vb.z & 0xffff0000u);
            *(LAS unsigned*)(dst + 6 * AV_ROW) = (va.w & 0xffffu) | (vb.w << 16); *(LAS unsigned*)(dst + 7 * AV_ROW) = (va.w >> 16) | (vb.w & 0xffff0000u); }
        __syncthreads();
        const int head = kvh * 8 + F.wave;
        const float sink2 = sinks[head] * 1.4426950408889634f;
#pragma unroll 1
        for (int qs = 0; qs < 4; ++qs) {
            const size_t qrow = (size_t)(b * SEQ + 128 * qblk + 32 * qs + col);
            bf16x8 qf[4];
#pragma unroll
            for (int s4 = 0; s4 < 4; ++s4) qf[s4] = *(const GAS bf16x8*)(Q + qrow * D + head * 64 + 16 * s4 + 8 * h);
            f32x16 sc[5];
#pragma unroll
            for (int t = 0; t < 5; ++t) {
#pragma unroll
                for (int r = 0; r < 16; ++r) sc[t][r] = 0.f;
#pragma unroll
                for (int s4 = 0; s4 < 4; ++s4) { const bf16x8 kf = *(const LAS bf16x8*)(Ks + (32 * (qs + t) + col) * AK_ROW + (16 * s4 + 8 * h) * 2);
                    sc[t] = __builtin_amdgcn_mfma_f32_32x32x16_bf16(kf, qf[s4], sc[t], 0, 0, 0); }
            }
            float mloc = -1e30f;
#pragma unroll
            for (int t = 0; t < 5; ++t) { const bool tile_ok = (qblk > 0) || (qs + t >= 4);
#pragma unroll
                for (int r = 0; r < 16; ++r) { const int row = (r & 3) + 8 * (r >> 2) + 4 * h;
                    bool ok = tile_ok; if (t == 0) ok = ok && (row > col); if (t == 4) ok = ok && (row <= col);
                    const float v = ok ? sc[t][r] * SC : -1e30f; sc[t][r] = v; mloc = fmaxf(mloc, v); } }
            float m2 = fmaxf(mloc, __shfl_xor(mloc, 32)); m2 = fmaxf(m2, sink2);
            float lloc = 0.f;
#pragma unroll
            for (int t = 0; t < 5; ++t)
#pragma unroll
                for (int r = 0; r < 16; ++r) { const float p = __builtin_amdgcn_exp2f(sc[t][r] - m2); sc[t][r] = p; lloc += p; }
            const float l = lloc + __shfl_xor(lloc, 32) + __builtin_amdgcn_exp2f(sink2 - m2);
            f32x16 o[2];
#pragma unroll
            for (int r = 0; r < 16; ++r) { o[0][r] = 0.f; o[1][r] = 0.f; }
#pragma unroll
            for (int t = 0; t < 5; ++t)
#pragma unroll
                for (int s2 = 0; s2 < 2; ++s2) {
                    v4u pw; pw.x = pk2(sc[t][8 * s2 + 0], sc[t][8 * s2 + 1]); pw.y = pk2(sc[t][8 * s2 + 2], sc[t][8 * s2 + 3]); pw.z = pk2(sc[t][8 * s2 + 4], sc[t][8 * s2 + 5]); pw.w = pk2(sc[t][8 * s2 + 6], sc[t][8 * s2 + 7]);
                    const bf16x8 pb = __builtin_bit_cast(bf16x8, pw);
#pragma unroll
                    for (int db = 0; db < 2; ++db) { const bf16x8 vf = *(const LAS bf16x8*)(Vt + (32 * db + col) * AV_ROW + (32 * (qs + t) + 16 * s2 + 8 * h) * 2);
                        o[db] = __builtin_amdgcn_mfma_f32_32x32x16_bf16(vf, pb, o[db], 0, 0, 0); }
                }
            const float inv = 1.0f / l;
#pragma unroll
            for (int db = 0; db < 2; ++db)
#pragma unroll
                for (int g4 = 0; g4 < 4; ++g4) { v2u w; w.x = pk2(o[db][4 * g4] * inv, o[db][4 * g4 + 1] * inv); w.y = pk2(o[db][4 * g4 + 2] * inv, o[db][4 * g4 + 3] * inv);
                    *(GAS v2u*)(O + qrow * D + head * 64 + 32 * db + 8 * g4 + 4 * h) = w; }
        }
    }
    __syncthreads();
}

#define GEMM_PHASE(EPI, Aptr, Wptr, NN, KK, ...) do { pg8::Gemm g{(const bf16*)(Aptr), (const bf16*)(Wptr), M, NN, KK}; pg8::StaticOrder S; S.init(M, NN, F.G, (int)blockIdx.x); \
        pg8::EPI E{__VA_ARGS__}; pg8::gemm_phase<pg8::EPI, pg8::StaticOrder, true, true>(F.lds + RING_OFF, g, S, E); } while (0)
__global__ void __launch_bounds__(NWAVES * 64, 2) fwd(Args args_unused) {
    extern __shared__ __attribute__((aligned(16))) unsigned char lds[];
    Frame F;
    F.lds = (LAS unsigned char*)lds;
    F.tid = threadIdx.x; F.lane = F.tid & 63; F.wave = __builtin_amdgcn_readfirstlane(F.tid >> 6);
    F.G = gridDim.x; { const int bx = blockIdx.x; F.vcu = (F.G % 8 == 0) ? (bx % 8) * (F.G / 8) + bx / 8 : bx; }
    for (int u = F.tid; u < (LDS_BYTES - LDSCTL_OFF) / 4; u += NWAVES * 64) ((LAS unsigned*)(F.lds + LDSCTL_OFF))[u] = 0u;
    __syncthreads();
    XcdBarrier bar = xcd_barrier_post((unsigned*)(kargs()->ws + WS_CTL) + CW_BAR, (volatile LAS unsigned*)(F.lds + MISC_OFF) + 8);
#define WSP(off) (kargs()->ws + (off))
#define RSP(i) ((float*)(kargs()->ws + WS_RS) + (size_t)(i) * M)
#define INF(i) ((const float*)kargs()->in[i])

    p0_prologue(F); xcd_barrier(bar);
    s5_phase(F); xcd_barrier(bar);
    GEMM_PHASE(EpiGlu, WSP(WS_GA), WSP(WS_WGLU), NGLU, D, (bf16*)WSP(WS_MB), D, INF(15), INF(17)); xcd_barrier(bar);
    { const KArgs a = kargs(); resid_phase<0>(F, (const bf16*)(a->ws + WS_MB), (const float*)a->in[0], (bf16*)(a->ws + WS_HB), nullptr, (float*)(a->ws + WS_RS) + M, (const float*)a->in[3]); } xcd_barrier(bar);
    GEMM_PHASE(EpiSwiglu, WSP(WS_HB), WSP(WS_WUP0), NUP, D, (bf16*)WSP(WS_ACT), FF);
    { const int nwg = (M / 256) * (NUP / 256), rem = nwg % (int)gridDim.x;
      if (rem == 0) p0_dn_tail(F, 0, (int)blockIdx.x, (int)gridDim.x); else if ((int)blockIdx.x >= rem) p0_dn_tail(F, 0, (int)blockIdx.x - rem, (int)gridDim.x - rem); }
    xcd_barrier(bar);
    GEMM_PHASE(EpiPlain, WSP(WS_ACT), WSP(WS_WDN0), D, FF, (bf16*)WSP(WS_MB), D, nullptr); xcd_barrier(bar);
    { const KArgs a = kargs(); resid_phase<1>(F, (const bf16*)(a->ws + WS_MB), nullptr, (bf16*)(a->ws + WS_HB), nullptr, (float*)(a->ws + WS_RS) + M, (const float*)a->in[5]); } xcd_barrier(bar);
    GEMM_PHASE(EpiQkv, WSP(WS_HB), WSP(WS_WQKV), NQKV, D, (bf16*)WSP(WS_Q), (bf16*)WSP(WS_K), (bf16*)WSP(WS_V), INF(19), (const int*)kargs()->in[1]); xcd_barrier(bar);
    attn_phase(F); xcd_barrier(bar);
    GEMM_PHASE(EpiPlain, WSP(WS_GA), WSP(WS_WO), D, D, (bf16*)WSP(WS_MB), D, INF(21)); xcd_barrier(bar);
    { const KArgs a = kargs(); resid_phase<1>(F, (const bf16*)(a->ws + WS_MB), nullptr, (bf16*)(a->ws + WS_HB), nullptr, (float*)(a->ws + WS_RS) + M, (const float*)a->in[3] + D); } xcd_barrier(bar);
    GEMM_PHASE(EpiSwiglu, WSP(WS_HB), WSP(WS_WUP1), NUP, D, (bf16*)WSP(WS_ACT), FF);
    { const int nwg = (M / 256) * (NUP / 256), rem = nwg % (int)gridDim.x;
      if (rem == 0) p0_dn_tail(F, 1, (int)blockIdx.x, (int)gridDim.x); else if ((int)blockIdx.x >= rem) p0_dn_tail(F, 1, (int)blockIdx.x - rem, (int)gridDim.x - rem); }
    xcd_barrier(bar);
    GEMM_PHASE(EpiPlain, WSP(WS_ACT), WSP(WS_WDN1), D, FF, (bf16*)WSP(WS_MB), D, nullptr); xcd_barrier(bar);
    { const KArgs a = kargs(); resid_phase<2>(F, (const bf16*)(a->ws + WS_MB), nullptr, (bf16*)(a->ws + WS_HB), a->out, (float*)(a->ws + WS_RS) + M, (const float*)a->in[5] + D); }
}

extern "C" void kernel_launch(void* const* d_in, const int* in_sizes, int n_in, void* d_out, int out_size, void* d_ws, size_t ws_size, hipStream_t stream) {
    static int grid = 0;
    if (grid == 0) {
        if (n_in != 26 || in_sizes[0] != M * D || out_size != M * D || ws_size < WS_END) { fprintf(stderr, "kernel_launch: unexpected shapes (n_in %d, in0 %d, out %d, ws %zu); nothing launched\n", n_in, n_in > 0 ? in_sizes[0] : -1, out_size, ws_size); grid = -1; return; }
        int dev = 0, cus = 0, per_cu = 0;
        if (hipGetDevice(&dev) != hipSuccess || hipDeviceGetAttribute(&cus, hipDeviceAttributeMultiprocessorCount, dev) != hipSuccess) { grid = -1; return; }
        if (hipFuncSetAttribute((const void*)fwd, hipFuncAttributeMaxDynamicSharedMemorySize, LDS_BYTES) != hipSuccess) { fprintf(stderr, "kernel_launch: hipFuncSetAttribute failed\n"); grid = -1; return; }
        if (hipOccupancyMaxActiveBlocksPerMultiprocessor(&per_cu, (const void*)fwd, NWAVES * 64, LDS_BYTES) != hipSuccess || per_cu < 1)
            fprintf(stderr, "kernel_launch: note: occupancy query reports %d workgroups per CU\n", per_cu);
        (void)hipGetLastError();
        grid = cus;
    }
    if (grid < 0) return;
    if (hipMemsetAsync((char*)d_ws + WS_CTL, 0, CTL_ZERO_BYTES, stream) != hipSuccess) { fprintf(stderr, "kernel_launch: hipMemsetAsync failed\n"); return; }
    Args a{};
    for (int i = 0; i < 26; ++i) a.in[i] = d_in[i];
    a.out = (float*)d_out; a.ws = (unsigned char*)d_ws;
    hipLaunchKernelGGL(fwd, dim3(grid), dim3(NWAVES * 64), LDS_BYTES, stream, a);
    const hipError_t le = hipPeekAtLastError();
    if (le != hipSuccess) fprintf(stderr, "kernel_launch: launch failed: %s\n", hipGetErrorName(le));
}
```

```cpp
#include <hip/hip_runtime.h>
#include <cstdio>
#include <cstdint>

namespace pg8 {
#define PG8_LAS __attribute__((address_space(3)))
typedef unsigned short bf16_t;
typedef short bf16x8 __attribute__((ext_vector_type(8)));
typedef float f32x4 __attribute__((ext_vector_type(4)));
typedef unsigned u32x4 __attribute__((ext_vector_type(4)));
constexpr int BM = 256, BK = 64, HALF = 128, HTB = HALF * BK * 2, STAGE_BYTES = 8 * HTB, NXCD = 8, WGM = 8;

__host__ __device__ __forceinline__ int lds_byte(int r, int c) { const int st = (r >> 4) * 2 + (c >> 5), rr = r & 15, cc = c & 31, ob = rr * 64 + cc * 2; return st * 1024 + (ob ^ (((ob >> 9) & 1) << 5)); }
__host__ __device__ __forceinline__ void stage_rc(int b, int& R, int& C) { const int st = b / 1024, sb = b % 1024, swz = sb ^ (((sb >> 9) & 1) << 5); R = (st >> 1) * 16 + swz / 64; C = (st & 1) * 32 + (swz % 64) / 2; }
__host__ __device__ __forceinline__ int perm32(int rho) { const int n = rho >> 4, i = rho & 15; return 8 * (i >> 2) + 4 * n + (i & 3); }

struct Unit { int pm, pn; };
struct Gemm { const bf16_t* A; const bf16_t* Bt; int M, N, K; };

struct StaticOrder {
    int nM, nN, nwg, G, c, wgm;
    __host__ __device__ void init(int M, int N, int G_, int c_, int wgm_ = WGM) { nM = M / BM; nN = N / BM; nwg = nM * nN; G = G_; c = c_; wgm = wgm_; }
    __host__ __device__ bool next(int i, Unit& u) const {
        const long L = (long)i * G + c; if (L >= nwg) return false;
        int wgid = (int)L; { const int q = nwg / NXCD, r = nwg % NXCD, xcd = wgid % NXCD, off = wgid / NXCD; wgid = (xcd < r ? xcd * (q + 1) : r * (q + 1) + (xcd - r) * q) + off; }
        const int nig = wgm * nN, gid = wgid / nig, fm = gid * wgm, gsz = (nM - fm) < wgm ? (nM - fm) : wgm;
        u.pm = fm + ((wgid % nig) % gsz); u.pn = (wgid % nig) / gsz; return true;
    }
    __device__ __forceinline__ void a_ready(const Unit&) const {}
    __device__ __forceinline__ void done(const Unit&) const {}
};

__device__ __forceinline__ unsigned cvt_pk_bf16(float lo, float hi) { unsigned r; asm volatile("v_cvt_pk_bf16_f32 %0, %1, %2" : "=v"(r) : "v"(lo), "v"(hi)); return r; }

#ifndef EPI_AUX
#define EPI_AUX 0
#endif
__device__ __forceinline__ void st16(const void* base, unsigned byte_off, u32x4 v) {
    const __amdgpu_buffer_rsrc_t r = __builtin_amdgcn_make_buffer_rsrc((void*)base, (short)0, 0x7fffffff, 0x00020000);
    __builtin_amdgcn_raw_buffer_store_b128(v, r, (int)byte_off, 0, EPI_AUX);
}

struct EpiPlain {
    static constexpr bool PERM = true, AFTER_DRAIN = false; static constexpr int NST = 16;
    bf16_t* O; int ldc; const float* bias;
    __device__ __forceinline__ void operator()(const f32x4 (&acc)[2][2][4][2], const Unit& u, int wr, int wc, int fr, int fq) const {
        const int row0 = u.pm * BM + wr * 64 + fr; const int col0 = u.pn * BM + wc * 32 + 8 * fq;
        f32x4 bv[2][2];
#pragma unroll
        for (int bj = 0; bj < 2; ++bj)
#pragma unroll
            for (int n = 0; n < 2; ++n) bv[bj][n] = bias ? *(const f32x4*)(bias + col0 + bj * HALF + 4 * n) : (f32x4){0.f, 0.f, 0.f, 0.f};
#pragma unroll
        for (int ai = 0; ai < 2; ++ai)
#pragma unroll
            for (int m = 0; m < 4; ++m) { const unsigned rowo = ((unsigned)(row0 + ai * HALF + m * 16) * (unsigned)ldc + (unsigned)col0) * 2u;
#pragma unroll
                for (int bj = 0; bj < 2; ++bj) { const f32x4 v0 = acc[ai][bj][m][0] + bv[bj][0], v1 = acc[ai][bj][m][1] + bv[bj][1];
                    u32x4 w; w.x = cvt_pk_bf16(v0[0], v0[1]); w.y = cvt_pk_bf16(v0[2], v0[3]); w.z = cvt_pk_bf16(v1[0], v1[1]); w.w = cvt_pk_bf16(v1[2], v1[3]);
                    st16(O, rowo + bj * HALF * 2, w); } }
    }
};
__device__ __forceinline__ float sigmoid_f(float x) { return __builtin_amdgcn_rcpf(1.0f + __builtin_amdgcn_exp2f(-1.4426950408889634f * x)); }
struct EpiGlu {
    static constexpr bool PERM = true, AFTER_DRAIN = false; static constexpr int NST = 8;
    bf16_t* O; int ldc; const float* b1; const float* b2;
    __device__ __forceinline__ void operator()(const f32x4 (&acc)[2][2][4][2], const Unit& u, int wr, int wc, int fr, int fq) const {
        const int row0 = u.pm * BM + wr * 64 + fr; const int col0 = u.pn * HALF + wc * 32 + 8 * fq;
        f32x4 bv[2][2];
#pragma unroll
        for (int n = 0; n < 2; ++n) { bv[0][n] = *(const f32x4*)(b1 + col0 + 4 * n); bv[1][n] = *(const f32x4*)(b2 + col0 + 4 * n); }
#pragma unroll
        for (int ai = 0; ai < 2; ++ai)
#pragma unroll
            for (int m = 0; m < 4; ++m) { const unsigned rowo = ((unsigned)(row0 + ai * HALF + m * 16) * (unsigned)ldc + (unsigned)col0) * 2u;
                f32x4 o[2];
#pragma unroll
                for (int n = 0; n < 2; ++n) { const f32x4 a = acc[ai][0][m][n] + bv[0][n], g = acc[ai][1][m][n] + bv[1][n];
#pragma unroll
                    for (int j = 0; j < 4; ++j) o[n][j] = a[j] * sigmoid_f(g[j]); }
                u32x4 w; w.x = cvt_pk_bf16(o[0][0], o[0][1]); w.y = cvt_pk_bf16(o[0][2], o[0][3]); w.z = cvt_pk_bf16(o[1][0], o[1][1]); w.w = cvt_pk_bf16(o[1][2], o[1][3]);
                st16(O, rowo, w); }
    }
};
struct EpiSwiglu {
    static constexpr bool PERM = true, AFTER_DRAIN = false; static constexpr int NST = 8;
    bf16_t* O; int ldc;
    __device__ __forceinline__ void operator()(const f32x4 (&acc)[2][2][4][2], const Unit& u, int wr, int wc, int fr, int fq) const {
        const int row0 = u.pm * BM + wr * 64 + fr; const int col0 = u.pn * HALF + wc * 32 + 8 * fq;
#pragma unroll
        for (int ai = 0; ai < 2; ++ai)
#pragma unroll
            for (int m = 0; m < 4; ++m) { const int row = row0 + ai * HALF + m * 16; const unsigned rowo = ((unsigned)row * (unsigned)ldc + (unsigned)col0) * 2u;
                f32x4 o[2];
#pragma unroll
                for (int n = 0; n < 2; ++n) { const f32x4 g = acc[ai][0][m][n], up = acc[ai][1][m][n];
#pragma unroll
                    for (int j = 0; j < 4; ++j) o[n][j] = g[j] * sigmoid_f(g[j]) * up[j]; }
                u32x4 w; w.x = cvt_pk_bf16(o[0][0], o[0][1]); w.y = cvt_pk_bf16(o[0][2], o[0][3]); w.z = cvt_pk_bf16(o[1][0], o[1][1]); w.w = cvt_pk_bf16(o[1][2], o[1][3]);
                st16(O, rowo, w); }
    }
};
struct EpiQkv {
    static constexpr bool PERM = true, AFTER_DRAIN = false; static constexpr int NST = 16;
    bf16_t* Q; bf16_t* Kb; bf16_t* Vb; const float* bias; const int* pos;
    __device__ __forceinline__ void operator()(const f32x4 (&acc)[2][2][4][2], const Unit& u, int wr, int wc, int fr, int fq) const {
        const int row0 = u.pm * BM + wr * 64 + fr; const int head = 4 * u.pn + wc;
        bf16_t* base; int ld, hcol;
        if (head < 64) { base = Q; ld = 4096; hcol = head * 64; } else if (head < 72) { base = Kb; ld = 512; hcol = (head - 64) * 64; } else { base = Vb; ld = 512; hcol = (head - 72) * 64; }
        const bool rope = head < 72;
        f32x4 bv[2][2];
#pragma unroll
        for (int bj = 0; bj < 2; ++bj)
#pragma unroll
            for (int n = 0; n < 2; ++n) bv[bj][n] = *(const f32x4*)(bias + head * 64 + 32 * bj + 8 * fq + 4 * n);
        float invf[2][4];
#pragma unroll
        for (int n = 0; n < 2; ++n)
#pragma unroll
            for (int j = 0; j < 4; ++j) invf[n][j] = exp2f(-(float)(8 * fq + 4 * n + j) * (13.287712379549449f / 32.0f));
#pragma unroll
        for (int ai = 0; ai < 2; ++ai)
#pragma unroll
            for (int m = 0; m < 4; ++m) { const int row = row0 + ai * HALF + m * 16; const float p = (float)pos[row];
                f32x4 v[2][2];
#pragma unroll
                for (int bj = 0; bj < 2; ++bj)
#pragma unroll
                    for (int n = 0; n < 2; ++n) v[bj][n] = acc[ai][bj][m][n] + bv[bj][n];
                if (rope) {
#pragma unroll
                    for (int n = 0; n < 2; ++n)
#pragma unroll
                        for (int j = 0; j < 4; ++j) { const float ang = p * invf[n][j]; const float t = __builtin_amdgcn_fractf(ang * 0.15915494309189535f);
                            const float sn = __builtin_amdgcn_sinf(t), cs = __builtin_amdgcn_cosf(t); const float x1 = v[0][n][j], x2 = v[1][n][j];
                            v[0][n][j] = x1 * cs - x2 * sn; v[1][n][j] = x2 * cs + x1 * sn; }
                }
                const unsigned rowo = ((unsigned)row * (unsigned)ld + (unsigned)(hcol + 8 * fq)) * 2u;
#pragma unroll
                for (int bj = 0; bj < 2; ++bj) { u32x4 w; w.x = cvt_pk_bf16(v[bj][0][0], v[bj][0][1]); w.y = cvt_pk_bf16(v[bj][0][2], v[bj][0][3]); w.z = cvt_pk_bf16(v[bj][1][0], v[bj][1][1]); w.w = cvt_pk_bf16(v[bj][1][2], v[bj][1][3]);
                    st16(base, rowo + 64 * bj, w); } }
    }
};

template <class Epi, class Sched, bool ALIGN_EPI = false, bool SP2 = false>
__device__ __forceinline__ void gemm_phase(PG8_LAS unsigned char* lds, const Gemm g, const Sched& S, const Epi& E) {
    int tid = threadIdx.x; asm volatile("" : "+v"(tid));
    const int wid = __builtin_amdgcn_readfirstlane(tid >> 6), lane = tid & 63, wr = wid >> 2, wc = wid & 3, fr = lane & 15, fq = lane >> 4;
    const int K = g.K, nt = K / BK;
#ifdef GEMM_STAGGER_TICKS
    { const unsigned long long t0 = __builtin_amdgcn_s_memrealtime(); const unsigned long long dl = (unsigned long long)(((blockIdx.x >> 3) & 3) * GEMM_STAGGER_TICKS);
      while (__builtin_amdgcn_s_memrealtime() - t0 < dl) __builtin_amdgcn_s_sleep(8); }
#endif
    unsigned voffA[2], voffB[2];
#pragma unroll
    for (int i = 0; i < 2; ++i) { int R, C; stage_rc(tid * 16 + i * 8192, R, C); const int Rb = Epi::PERM ? ((R & ~31) + perm32(R & 31)) : R;
        voffA[i] = (unsigned)(R * K + C) * 2u; voffB[i] = (unsigned)(Rb * K + C) * 2u; }
    const size_t kstep = (size_t)(BK * 2);
    const size_t hstep = (size_t)HALF * K * 2;
    const size_t tstep = 2 * hstep;
    const unsigned ldsw = (unsigned)wid * 1024u;
    const int aoff = lds_byte(wr * 64 + fr, fq * 8), boff = lds_byte(wc * 32 + fr, fq * 8);
#define PG8_SA(b, h) (((b) * 2 + (h)) * HTB)
#define PG8_SB(b, h) ((4 + (b) * 2 + (h)) * HTB)
#define PG8_STAGE(bufoff, gbase, voff) do { _Pragma("unroll") for (int _i = 0; _i < 2; ++_i) \
        __builtin_amdgcn_global_load_lds((const unsigned*)((const char*)(gbase) + (voff)[_i]), (PG8_LAS unsigned*)(lds + (bufoff) + ldsw + _i * 8192), 16, 0, 0); } while (0)
#define PG8_LDA(dst, b, h) do { _Pragma("unroll") for (int m = 0; m < 4; ++m) _Pragma("unroll") for (int k = 0; k < 2; ++k) dst[m][k] = *(const PG8_LAS bf16x8*)(lds + PG8_SA(b, h) + aoff + m * 2048 + k * 1024); } while (0)
#define PG8_LDB(dst, b, h) do { _Pragma("unroll") for (int n = 0; n < 2; ++n) _Pragma("unroll") for (int k = 0; k < 2; ++k) dst[n][k] = *(const PG8_LAS bf16x8*)(lds + PG8_SB(b, h) + boff + n * 2048 + k * 1024); } while (0)
#define PG8_MMA(ai, bj, At, Bt) do { __builtin_amdgcn_s_setprio(1); _Pragma("unroll") for (int m = 0; m < 4; ++m) _Pragma("unroll") for (int n = 0; n < 2; ++n) _Pragma("unroll") for (int k = 0; k < 2; ++k) \
        acc[ai][bj][m][n] = __builtin_amdgcn_mfma_f32_16x16x32_bf16(Bt[n][k], At[m][k], acc[ai][bj][m][n], 0, 0, 0); __builtin_amdgcn_s_setprio(0); } while (0)
#define PG8_WAIT_V(n) asm volatile("s_waitcnt vmcnt(" #n ")" ::: "memory")
#define PG8_WAIT_L(n) asm volatile("s_waitcnt lgkmcnt(" #n ")" ::: "memory")
#define PG8_WAIT_VN(N) asm volatile("s_waitcnt vmcnt(%0)" :: "n"(N) : "memory")
#define PG8_BAR __builtin_amdgcn_s_barrier()
#define PG8_SCHED __builtin_amdgcn_sched_barrier(0)
    Unit cur, nxt; int ui = 0;
    if (!S.next(0, cur)) return;
    f32x4 acc[2][2][4][2];
#pragma unroll
    for (int a = 0; a < 2; ++a)
#pragma unroll
        for (int b = 0; b < 2; ++b)
#pragma unroll
            for (int m = 0; m < 4; ++m)
#pragma unroll
                for (int n = 0; n < 2; ++n) acc[a][b][m][n] = (f32x4){0.f, 0.f, 0.f, 0.f};
    bf16x8 At[4][2], B0[2][2], B1[2][2];
    const char* cA = (const char*)g.A + (size_t)cur.pm * tstep; const char* cB = (const char*)g.Bt + (size_t)cur.pn * tstep;
    S.a_ready(cur);
    if constexpr (SP2) {
        PG8_STAGE(PG8_SB(0, 0), cB, voffB); PG8_STAGE(PG8_SB(0, 1), cB + hstep, voffB); PG8_STAGE(PG8_SA(0, 0), cA, voffA); PG8_STAGE(PG8_SA(0, 1), cA + hstep, voffA);
        if (wr == 1) PG8_BAR;
        PG8_WAIT_V(2); PG8_BAR;
        PG8_STAGE(PG8_SB(1, 0), cB + kstep, voffB); PG8_STAGE(PG8_SA(1, 0), cA + kstep, voffA); PG8_STAGE(PG8_SB(1, 1), cB + hstep + kstep, voffB);
        PG8_WAIT_V(6); PG8_BAR;
    } else {
        PG8_STAGE(PG8_SB(0, 0), cB, voffB); PG8_STAGE(PG8_SA(0, 0), cA, voffA); PG8_STAGE(PG8_SB(0, 1), cB + hstep, voffB); PG8_STAGE(PG8_SA(0, 1), cA + hstep, voffA);
        if (wr == 1) PG8_BAR;
        PG8_WAIT_V(4); PG8_BAR;
        PG8_STAGE(PG8_SB(1, 0), cB + kstep, voffB); PG8_STAGE(PG8_SA(1, 0), cA + kstep, voffA); PG8_STAGE(PG8_SB(1, 1), cB + hstep + kstep, voffB);
        PG8_WAIT_V(6); PG8_BAR;
    }
    for (;;) {
        const bool has_next = S.next(ui + 1, nxt);
        const char* nA = has_next ? (const char*)g.A + (size_t)nxt.pm * tstep : cA; const char* nB = has_next ? (const char*)g.Bt + (size_t)nxt.pn * tstep : cB;
        for (int t = 0; t < nt; t += 2) {
            const bool last = (t == nt - 2);
            const char* a1 = cA + (size_t)(t + 1) * kstep;
            const char* a2 = last ? nA : cA + (size_t)(t + 2) * kstep; const char* b2 = last ? nB : cB + (size_t)(t + 2) * kstep;
            const char* a3 = a2 + kstep; const char* b3 = b2 + kstep;
            if (last && has_next) S.a_ready(nxt);
            if constexpr (SP2) {
            PG8_LDB(B0, 0, 0); PG8_LDB(B1, 0, 1); PG8_SCHED; PG8_LDA(At, 0, 0); PG8_STAGE(PG8_SA(1, 1), a1 + hstep, voffA);
            PG8_WAIT_V(8); PG8_WAIT_L(0); PG8_BAR; PG8_MMA(0, 0, At, B0); PG8_MMA(0, 1, At, B1); PG8_BAR; PG8_SCHED;
            PG8_LDA(At, 0, 1); PG8_STAGE(PG8_SB(0, 0), b2, voffB); PG8_STAGE(PG8_SB(0, 1), b2 + hstep, voffB); PG8_STAGE(PG8_SA(0, 0), a2, voffA);
            PG8_WAIT_V(8); PG8_WAIT_L(0); PG8_BAR; PG8_MMA(1, 0, At, B0); PG8_MMA(1, 1, At, B1); PG8_BAR; PG8_SCHED;
            PG8_LDB(B0, 1, 0); PG8_LDB(B1, 1, 1); PG8_SCHED; PG8_LDA(At, 1, 0); PG8_STAGE(PG8_SA(0, 1), a2 + hstep, voffA);
            PG8_WAIT_V(8); PG8_WAIT_L(0); PG8_BAR; PG8_MMA(0, 0, At, B0); PG8_MMA(0, 1, At, B1); PG8_BAR; PG8_SCHED;
            PG8_LDA(At, 1, 1); PG8_STAGE(PG8_SB(1, 0), b3, voffB); PG8_STAGE(PG8_SB(1, 1), b3 + hstep, voffB); PG8_STAGE(PG8_SA(1, 0), a3, voffA);
            PG8_WAIT_V(8); PG8_WAIT_L(0); PG8_BAR; PG8_MMA(1, 0, At, B0); PG8_MMA(1, 1, At, B1); PG8_BAR; PG8_SCHED;
            } else {
            PG8_LDB(B0, 0, 0); PG8_SCHED; PG8_LDA(At, 0, 0); PG8_STAGE(PG8_SA(1, 1), a1 + hstep, voffA);
            PG8_WAIT_L(8); PG8_BAR; PG8_WAIT_L(0); PG8_MMA(0, 0, At, B0); PG8_BAR; PG8_SCHED;
            PG8_LDB(B1, 0, 1); PG8_STAGE(PG8_SB(0, 0), b2, voffB);
            PG8_BAR; PG8_WAIT_L(0); PG8_MMA(0, 1, At, B1); PG8_BAR;
            PG8_LDA(At, 0, 1); PG8_STAGE(PG8_SA(0, 0), a2, voffA);
            PG8_BAR; PG8_WAIT_L(0); PG8_MMA(1, 0, At, B0); PG8_BAR; PG8_SCHED;
            PG8_STAGE(PG8_SB(0, 1), b2 + hstep, voffB);
            PG8_WAIT_V(6); PG8_BAR; PG8_MMA(1, 1, At, B1); PG8_BAR;
            PG8_LDB(B0, 1, 0); PG8_SCHED; PG8_LDA(At, 1, 0); PG8_STAGE(PG8_SA(0, 1), a2 + hstep, voffA);
            PG8_WAIT_L(8); PG8_BAR; PG8_WAIT_L(0); PG8_MMA(0, 0, At, B0); PG8_BAR; PG8_SCHED;
            PG8_LDB(B1, 1, 1); PG8_STAGE(PG8_SB(1, 0), b3, voffB);
            PG8_BAR; PG8_WAIT_L(0); PG8_MMA(0, 1, At, B1); PG8_BAR;
            PG8_LDA(At, 1, 1); PG8_STAGE(PG8_SA(1, 0), a3, voffA);
            PG8_BAR; PG8_WAIT_L(0); PG8_MMA(1, 0, At, B0); PG8_BAR; PG8_SCHED;
            PG8_STAGE(PG8_SB(1, 1), b3 + hstep, voffB);
            PG8_WAIT_V(6); PG8_BAR; PG8_MMA(1, 1, At, B1); PG8_BAR;
            }
        }
        if constexpr (ALIGN_EPI) { if (wr == 0) PG8_BAR; }
        if constexpr (!Epi::AFTER_DRAIN) { E(acc, cur, wr, wc, fr, fq); S.done(cur); }
        if (!has_next) break;
#pragma unroll
        for (int a = 0; a < 2; ++a)
#pragma unroll
            for (int b = 0; b < 2; ++b)
#pragma unroll
                for (int m = 0; m < 4; ++m)
#pragma unroll
                    for (int n = 0; n < 2; ++n) acc[a][b][m][n] = (f32x4){0.f, 0.f, 0.f, 0.f};
        cur = nxt; cA = nA; cB = nB; ++ui;
        if constexpr (ALIGN_EPI) { if (wr == 1) PG8_BAR; }
    }
    PG8_WAIT_V(0);
    if constexpr (!ALIGN_EPI) { if (wr == 0) PG8_BAR; }
    PG8_BAR;
#undef PG8_SA
#undef PG8_SB
#undef PG8_STAGE
#undef PG8_LDA
#undef PG8_LDB
#undef PG8_MMA
#undef PG8_WAIT_V
#undef PG8_WAIT_L
#undef PG8_WAIT_VN
#undef PG8_BAR
#undef PG8_SCHED
}
}

constexpr int NWAVES = 8;
constexpr int D = 4096, NB = 4, SEQ = 4096, M = NB * SEQ, FF = 11008;
constexpr int NGLU = 2 * D, NUP = 2 * FF, NQKV = 5120;
constexpr int S5G = 256, S5P = 64, S5C = 16;
constexpr float EPS = 1e-6f;

constexpr size_t MiB = 1u << 20;
constexpr size_t WS_CTL = 0, CTL_ZERO_BYTES = 1 * MiB;
constexpr size_t WS_RS = 1 * MiB;
constexpr size_t WS_WGLU = 2 * MiB, WS_WUP0 = 66 * MiB, WS_WDN0 = 238 * MiB, WS_WQKV = 324 * MiB, WS_WO = 364 * MiB, WS_WUP1 = 396 * MiB, WS_WDN1 = 568 * MiB;
constexpr size_t WS_HB = 654 * MiB, WS_GA = 782 * MiB, WS_MB = 910 * MiB, WS_ACT = 1038 * MiB, WS_END = 1382 * MiB;
constexpr size_t WS_Q = WS_ACT, WS_K = WS_ACT + 128 * MiB, WS_V = WS_ACT + 144 * MiB;
constexpr int CW_BAR = 4096;

constexpr int RING_OFF = 0, RING_BYTES = 131072;
constexpr int LDSCTL_OFF = RING_BYTES, MISC_OFF = LDSCTL_OFF + 320;
constexpr int LDS_BYTES = 147456;

#define GAS __attribute__((address_space(1)))
#define LAS __attribute__((address_space(3)))
typedef unsigned short bf16;
typedef unsigned v4u __attribute__((ext_vector_type(4)));
typedef unsigned v2u __attribute__((ext_vector_type(2)));
typedef float f32x4 __attribute__((ext_vector_type(4)));
typedef float f32x16 __attribute__((ext_vector_type(16)));
typedef short bf16x8 __attribute__((ext_vector_type(8)));
using bf16x2 = __attribute__((ext_vector_type(2))) __bf16;
typedef GAS unsigned gu32;
#define LDS_WAIT() asm volatile("s_waitcnt lgkmcnt(0)" ::: "memory")
#define VM_WAIT() asm volatile("s_waitcnt vmcnt(0)" ::: "memory")
__device__ __forceinline__ unsigned pk2(float lo, float hi) { return pg8::cvt_pk_bf16(lo, hi); }
__device__ __forceinline__ float bf_lo(unsigned w) { return __uint_as_float(w << 16); }
__device__ __forceinline__ float bf_hi(unsigned w) { return __uint_as_float(w & 0xffff0000u); }

#define XB_TMO      128
#define XB_XCNT(j)  (256  + 64 * (j))
#define XB_XSUB(j)  (1280 + 64 * (j))
#define XB_XGEN(j)  (2304 + 64 * (j))
#define XB_TOP      3328
#define XB_TOPGEN   3392
#define XCD_BAR_WORDS 3456
#define XB_SPIN_CAP (1u << 18)

__device__ __forceinline__ unsigned xb_ld(unsigned* p)              { return __hip_atomic_load(p, __ATOMIC_RELAXED, __HIP_MEMORY_SCOPE_AGENT); }
__device__ __forceinline__ unsigned xb_add(unsigned* p, unsigned v) { return __hip_atomic_fetch_add(p, v, __ATOMIC_RELAXED, __HIP_MEMORY_SCOPE_AGENT); }
__device__ __forceinline__ unsigned xb_xcc_id() { return (unsigned)__builtin_amdgcn_s_getreg((3 << 11) | 20) & 0xFu; }
#define XB_SPIN(cond, bar) do { unsigned _sp = 0; while (cond) { __builtin_amdgcn_s_sleep(1); \
    if ((++_sp & 255u) == 0u) { if (xb_ld(&(bar)[XB_TMO])) break; if (_sp > XB_SPIN_CAP) { atomicAdd(&(bar)[XB_TMO], 1u); break; } } } } while (0)

struct XcdBarrier {
    unsigned* bar; unsigned x;
    volatile LAS unsigned* st;
};
__device__ __forceinline__ XcdBarrier xcd_barrier_post(unsigned* bar, volatile LAS unsigned* st) {
    XcdBarrier b; b.bar = bar; b.x = xb_xcc_id(); b.st = st;
    if (threadIdx.x == 0) (void)xb_add(&bar[XB_XCNT(b.x)], 1u);
    return b;
}
__device__ __forceinline__ void xcd_barrier_complete(unsigned* bar, unsigned x, unsigned& nloc, unsigned& nx) {
    const unsigned G = gridDim.x * gridDim.y * gridDim.z;
    unsigned sum, cnt, mine, sp = 0u;
    for (;;) {
        sum = 0u; cnt = 0u; mine = 0u;
#pragma unroll
        for (unsigned j = 0; j < 16; ++j) { const unsigned c = xb_ld(&bar[XB_XCNT(j)]); sum += c; cnt += (c > 0u) ? 1u : 0u; mine = (j == x) ? c : mine; }
        if (sum == G) break;
        __builtin_amdgcn_s_sleep(1);
        if ((++sp & 255u) == 0u) { if (xb_ld(&bar[XB_TMO])) break; if (sp > XB_SPIN_CAP) { atomicAdd(&bar[XB_TMO], 1u); break; } }
    }
    nloc = mine > 0u ? mine : 1u; nx = cnt > 0u ? cnt : 1u;
}
__device__ __forceinline__ void xcd_barrier(const XcdBarrier& b) {
    asm volatile("s_waitcnt vmcnt(0)" ::: "memory");
    __syncthreads();
    if (threadIdx.x == 0) {
        unsigned* bar = b.bar;
        __builtin_amdgcn_s_waitcnt(0);
        unsigned nloc = b.st[0], nx = b.st[1];
        if (nloc == 0u) { xcd_barrier_complete(bar, b.x, nloc, nx); b.st[0] = nloc; b.st[1] = nx; }
        const unsigned old = xb_add(&bar[XB_XSUB(b.x)], 1u);
        const unsigned gen = old / nloc;
        if (old + 1u == (gen + 1u) * nloc) {
            __builtin_amdgcn_fence(__ATOMIC_RELEASE, "agent");
            asm volatile("s_waitcnt vmcnt(0)" ::: "memory");
            const unsigned og = xb_add(&bar[XB_TOP], 1u);
            const unsigned tg = og / nx;
            if (og + 1u == (tg + 1u) * nx) xb_add(&bar[XB_TOPGEN], 1u);
            else XB_SPIN(xb_ld(&bar[XB_TOPGEN]) == tg, bar);
            __builtin_amdgcn_fence(__ATOMIC_ACQUIRE, "agent");
            xb_add(&bar[XB_XGEN(b.x)], 1u);
            asm volatile("s_waitcnt vmcnt(0)" ::: "memory");
        } else {
            XB_SPIN(xb_ld(&bar[XB_XGEN(b.x)]) == gen, bar);
            __builtin_amdgcn_fence(__ATOMIC_ACQUIRE, "agent");
            asm volatile("s_waitcnt vmcnt(0)" ::: "memory");
        }
    }
    __syncthreads();
}

struct Frame {
    LAS unsigned char* lds;
    int tid, lane, wave;
    int vcu, G;
};
__device__ __forceinline__ void refresh(Frame& F) { int t = threadIdx.x; asm volatile("" : "+v"(t)); F.tid = t; F.lane = t & 63; F.wave = __builtin_amdgcn_readfirstlane(t >> 6); }
__device__ __forceinline__ float wave_sum(float v) {
#pragma unroll
    for (int o = 1; o < 64; o <<= 1) v += __shfl_xor(v, o);
    return v;
}

struct P0Job { const float* W; bf16* WT; const float* gain; int K, N, drow0, dstep, k0, n0; };
__device__ __forceinline__ void p0_load(const P0Job& J, f32x4 (&a)[8], f32x4 (&b)[8], int lane) {
    const int ksub = lane >> 4, n4 = (lane & 15) * 4;
    const float* wp = J.W + (size_t)(J.k0 + 2 * ksub) * J.N + J.n0 + n4;
#pragma unroll
    for (int i = 0; i < 8; ++i) { a[i] = *(const GAS f32x4*)(wp + (size_t)(8 * i) * J.N); b[i] = *(const GAS f32x4*)(wp + (size_t)(8 * i + 1) * J.N); }
}
__device__ __forceinline__ void p0_to_lds(const P0Job& J, f32x4 (&a)[8], f32x4 (&b)[8], LAS unsigned char* scr, int lane) {
    const int ksub = lane >> 4, n4 = (lane & 15) * 4;
    if (J.gain) {
#pragma unroll
        for (int i = 0; i < 8; ++i) { const float ga = J.gain[J.k0 + 8 * i + 2 * ksub], gb = J.gain[J.k0 + 8 * i + 2 * ksub + 1]; a[i] = a[i] * ga; b[i] = b[i] * gb; }
    }
#pragma unroll
    for (int i = 0; i < 8; ++i)
#pragma unroll
        for (int e = 0; e < 4; ++e) { const int n = n4 + e; *(LAS unsigned*)(scr + n * 128 + (((4 * i + ksub) ^ (2 * (n >> 2))) << 2)) = pk2(a[i][e], b[i][e]); }
    LDS_WAIT(); asm volatile("" ::: "memory");
}
__device__ __forceinline__ void p0_store(const P0Job& J, LAS unsigned char* scr, int lane) {
    const int c = lane & 7;
#pragma unroll
    for (int j = 0; j < 8; ++j) { const int n = (lane >> 3) + 8 * j;
        v4u v = *(const LAS v4u*)(scr + n * 128 + ((c ^ (n >> 3)) << 4));
        if ((n >> 2) & 1) { const unsigned t0 = v.x, t1 = v.y; v.x = v.z; v.y = v.w; v.z = t0; v.w = t1; }
        *(GAS v4u*)(J.WT + (size_t)(J.drow0 + (n & 31) + J.dstep * (n >> 5)) * J.K + J.k0 + 8 * c) = v; }
    LDS_WAIT(); asm volatile("" ::: "memory");
}
__device__ __forceinline__ int map_pair(int n0, int bj) { return 256 * (n0 >> 7) + 128 * bj + (n0 & 127); }
__device__ __forceinline__ int map_qkv(int n0) { const int head = n0 >> 6; return 256 * (head >> 2) + 32 * (head & 3); }

struct Args { const void* in[26]; float* out; unsigned char* ws; };
typedef const __attribute__((address_space(4))) Args* KArgs;
__device__ __forceinline__ KArgs kargs() { KArgs p = (KArgs)__builtin_amdgcn_kernarg_segment_ptr(); asm volatile("" : "+s"(p)); return p; }

__device__ __forceinline__ void p0_prologue(Frame& F) {
    refresh(F);
    const KArgs A_ = kargs();
    LAS unsigned char* scr = F.lds + RING_OFF + F.wave * 16384;
    const int gw = F.vcu * NWAVES + F.wave, NGW = F.G * NWAVES;
    unsigned char* ws = A_->ws;
    constexpr int I_SQ = (D / 64) * (D / 64);
    constexpr int I_UP = (D / 64) * (FF / 64);
    constexpr int I_QKV = (D / 64) * (NQKV / 64);
    constexpr int NITEMS = 2 * I_SQ + 2 * (2 * I_UP) + I_QKV + I_SQ;
    const float* npm = (const float*)A_->in[2];
    const float* npf = (const float*)A_->in[4];
    auto decode = [&](int it, P0Job& J) {
        int r = it;
        if (r < 2 * I_SQ) { const int bj = r >= I_SQ; r -= bj * I_SQ; const int nkb = D / 64, kb = r % nkb, nb = r / nkb;
            J = P0Job{(const float*)A_->in[bj ? 16 : 14], (bf16*)(ws + WS_WGLU), nullptr, D, D, map_pair(64 * nb, bj), 32, 64 * kb, 64 * nb}; return; }
        r -= 2 * I_SQ;
#pragma unroll
        for (int l = 0; l < 2; ++l) {
            if (r < 2 * I_UP) { const int bj = r >= I_UP; r -= bj * I_UP; const int nkb = D / 64, kb = r % nkb, nb = r / nkb;
                J = P0Job{(const float*)A_->in[bj ? 24 : 23] + (size_t)l * D * FF, (bf16*)(ws + (l ? WS_WUP1 : WS_WUP0)), npf + l * D, D, FF, map_pair(64 * nb, bj), 32, 64 * kb, 64 * nb}; return; }
            r -= 2 * I_UP;
        }
        if (r < I_QKV) { const int nkb = D / 64, kb = r % nkb, nb = r / nkb;
            J = P0Job{(const float*)A_->in[18], (bf16*)(ws + WS_WQKV), npm + D, D, NQKV, map_qkv(64 * nb), 128, 64 * kb, 64 * nb}; return; }
        r -= I_QKV;
        { const int nkb = D / 64, kb = r % nkb, nb = r / nkb;
            J = P0Job{(const float*)A_->in[20], (bf16*)(ws + WS_WO), nullptr, D, D, 64 * nb, 32, 64 * kb, 64 * nb}; }
    };
    {
        f32x4 a[8], b[8]; P0Job J, Jn;
        int it = gw;
        if (it < NITEMS) { decode(it, J); p0_load(J, a, b, F.lane); }
        while (it < NITEMS) {
            p0_to_lds(J, a, b, scr, F.lane);
            const int itn = it + NGW;
            if (itn < NITEMS) { decode(itn, Jn); p0_load(Jn, a, b, F.lane); }
            p0_store(J, scr, F.lane);
            J = Jn; it = itn;
        }
    }
    const float* x = (const float*)A_->in[0]; float* rs0 = (float*)(ws + WS_RS);
    for (int m = gw; m < M; m += NGW) {
        const GAS f32x4* xr = (const GAS f32x4*)(x + (size_t)m * D) + F.lane; float s = 0.f;
#pragma unroll
        for (int j = 0; j < 16; ++j) { const f32x4 v = xr[64 * j]; s += (v.x * v.x + v.y * v.y) + (v.z * v.z + v.w * v.w); }
        s = wave_sum(s);
        if (F.lane == 0) rs0[m] = 1.0f / sqrtf(s * (1.0f / D) + EPS);
    }
}

__device__ __forceinline__ void p0_dn_tail(Frame& F, int layer, int rank, int nranks) {
    refresh(F);
    const KArgs A_ = kargs();
    LAS unsigned char* scr = F.lds + RING_OFF + F.wave * 16384;
    const float* W = (const float*)A_->in[25] + (size_t)layer * FF * D;
    bf16* WT = (bf16*)(A_->ws + (layer ? WS_WDN1 : WS_WDN0));
    constexpr int I_DN = (FF / 64) * (D / 64), NKB = FF / 64;
    const int NGW = nranks * NWAVES;
    f32x4 a[8], b[8]; P0Job J, Jn;
    int it = rank * NWAVES + F.wave;
    if (it < I_DN) { J = P0Job{W, WT, nullptr, FF, D, 64 * (it / NKB), 32, 64 * (it % NKB), 64 * (it / NKB)}; p0_load(J, a, b, F.lane); }
    while (it < I_DN) {
        p0_to_lds(J, a, b, scr, F.lane);
        const int itn = it + NGW;
        if (itn < I_DN) { Jn = P0Job{W, WT, nullptr, FF, D, 64 * (itn / NKB), 32, 64 * (itn % NKB), 64 * (itn / NKB)}; p0_load(Jn, a, b, F.lane); }
        p0_store(J, scr, F.lane);
        J = Jn; it = itn;
    }
}

__device__ __forceinline__ bf16x8 pack8(const f32x4 a, const f32x4 b) {
    v4u w; w.x = pk2(a.x, a.y); w.y = pk2(a.z, a.w); w.z = pk2(b.x, b.y); w.w = pk2(b.z, b.w); return __builtin_bit_cast(bf16x8, w);
}
__device__ __forceinline__ float gelu_tanh(float y) {
    const float z = 0.7978845608028654f * (y + 0.044715f * y * y * y);
    return y * __builtin_amdgcn_rcpf(1.0f + __builtin_amdgcn_exp2f(-2.0f * 1.4426950408889634f * z));
}
template <bool FULL>
__device__ __forceinline__ void s5_run(const float* __restrict__ x, const float* __restrict__ rs0, bf16* __restrict__ G, LAS float* U, LAS unsigned char* Sim, int g, int bp, int t0, int nt, int lane,
                                       const bf16x8 (&Bf)[4], const bf16x8 (&Cf)[4], const float (&lr)[2], const float (&li)[2], f32x4 d4, f32x4 gq, float (&sr)[2], float (&si)[2]) {
    const int n = lane & 31, h = lane >> 5, cc = lane & 15, kq = lane >> 4;
    f32x4 xv[4]; float rv[4];
#define S5_ISSUE(L0) do { _Pragma("unroll") for (int i = 0; i < 4; ++i) { const int row = i * 16 + (lane >> 2); const int grow = (2 * bp + (row >> 5)) * SEQ + (L0) + (row & 31); \
        xv[i] = *(const f32x4*)(x + (size_t)grow * D + g * S5C + 4 * (lane & 3)); rv[i] = rs0[grow]; } } while (0)
    S5_ISSUE(t0);
    for (int L0 = t0; L0 < t0 + nt; L0 += 32) {
#pragma unroll
        for (int i = 0; i < 4; ++i) { const int row = i * 16 + (lane >> 2); *(LAS f32x4*)(U + row * 20 + 4 * (lane & 3)) = xv[i] * rv[i] * gq; }
        if (L0 + 32 < t0 + nt) S5_ISSUE(L0 + 32);
#pragma unroll 1
        for (int st = 0; st < 2; ++st) {
            const LAS float* up = U + (((n >> 2) & 1) * 32 + 16 * st + (n & 3) + 4 * (n >> 3)) * 20 + 8 * h;
            const bf16x8 Af = pack8(*(const LAS f32x4*)up, *(const LAS f32x4*)(up + 4));
            f32x16 acc[4];
#pragma unroll
            for (int nb = 0; nb < 4; ++nb) { f32x16 z;
#pragma unroll
                for (int r = 0; r < 16; ++r) z[r] = 0.f;
                acc[nb] = __builtin_amdgcn_mfma_f32_32x32x16_bf16(Af, Bf[nb], z, 0, 0, 0); }
#pragma unroll
            for (int r = 0; r < 16; ++r)
#pragma unroll
                for (int q = 0; q < 2; ++q) {
                    const float nr = fmaf(lr[q], sr[q], fmaf(-li[q], si[q], acc[2 * q][r]));
                    const float ni = fmaf(lr[q], si[q], fmaf(li[q], sr[q], acc[2 * q + 1][r]));
                    sr[q] = nr; si[q] = ni;
                    if (FULL) *(LAS unsigned*)(Sim + (16 * h + r) * 288 + 4 * (n + 32 * q)) = pk2(nr, ni);
                }
            if (FULL) {
#pragma unroll
                for (int hb = 0; hb < 2; ++hb) {
                    f32x4 y = {0.f, 0.f, 0.f, 0.f};
#pragma unroll
                    for (int ks = 0; ks < 4; ++ks) { const bf16x8 sb = *(const LAS bf16x8*)(Sim + (16 * hb + cc) * 288 + (32 * ks + 8 * kq) * 2);
                        y = __builtin_amdgcn_mfma_f32_16x16x32_bf16(Cf[ks], sb, y, 0, 0, 0); }
                    const f32x4 u4 = *(const LAS f32x4*)(U + (hb * 32 + 16 * st + cc) * 20 + 4 * kq);
                    const f32x4 v = y + d4 * u4;
                    v2u w; w.x = pk2(gelu_tanh(v.x), gelu_tanh(v.y)); w.y = pk2(gelu_tanh(v.z), gelu_tanh(v.w));
                    *(GAS v2u*)(G + (size_t)((2 * bp + hb) * SEQ + L0 + 16 * st + cc) * D + g * S5C + 4 * kq) = w;
                }
            }
        }
    }
#undef S5_ISSUE
}
__device__ __forceinline__ void s5_phase(Frame& F) {
    refresh(F);
    const KArgs A_ = kargs();
    const float* x = (const float*)A_->in[0]; const float* rs0 = (const float*)(A_->ws + WS_RS); const float* gain = (const float*)A_->in[2];
    const float* lam_re = (const float*)A_->in[6]; const float* lam_im = (const float*)A_->in[7]; const float* log_step = (const float*)A_->in[8];
    const float* b_re = (const float*)A_->in[9]; const float* b_im = (const float*)A_->in[10]; const float* c_re = (const float*)A_->in[11]; const float* c_im = (const float*)A_->in[12];
    const float* dsk = (const float*)A_->in[13]; bf16* G = (bf16*)(A_->ws + WS_GA);
    const int lane = F.lane, w = F.wave, bp = w >> 2, seg = w & 3;
    constexpr int SEGT = SEQ / 4;
    LAS unsigned char* wl = F.lds + RING_OFF + w * 14336;
    LAS float* U = (LAS float*)wl;
    LAS unsigned char* Sim = wl + 5120;
    LAS float* E = (LAS float*)(F.lds + RING_OFF + 8 * 14336);
    const int n = lane & 31, h = lane >> 5, cc = lane & 15, kq = lane >> 4;
    for (int g = F.vcu; g < S5G; g += F.G) {
        const float stp = expf(log_step[g]);
        float lr[2], li[2], Lr[2], Li[2]; bf16x8 Bf[4];
#pragma unroll
        for (int q = 0; q < 2; ++q) { const int p = n + 32 * q;
            const float are = lam_re[g * S5P + p], aim = lam_im[g * S5P + p];
            const float zr = are * stp, zi = aim * stp;
            const float e = expf(zr); float sn, cs; sincosf(zi, &sn, &cs);
            lr[q] = e * cs; li[q] = e * sn;
            const float e2 = expf(zr * (float)SEGT); float sn2, cs2; sincosf(zi * (float)SEGT, &sn2, &cs2);
            Lr[q] = e2 * cs2; Li[q] = e2 * sn2;
            const float nr = lr[q] - 1.0f, ni = li[q], den = 1.0f / (are * are + aim * aim);
            const float cr = (nr * are + ni * aim) * den, ci = (ni * are - nr * aim) * den;
            const float* brp = b_re + ((size_t)(g * S5P + p) * S5C + 8 * h); const float* bip = b_im + ((size_t)(g * S5P + p) * S5C + 8 * h);
            const f32x4 br0 = *(const f32x4*)brp, br1 = *(const f32x4*)(brp + 4), bi0 = *(const f32x4*)bip, bi1 = *(const f32x4*)(bip + 4);
            Bf[2 * q] = pack8(cr * br0 - ci * bi0, cr * br1 - ci * bi1);
            Bf[2 * q + 1] = pack8(cr * bi0 + ci * br0, cr * bi1 + ci * br1); }
        bf16x8 Cf[4];
#pragma unroll
        for (int ks = 0; ks < 4; ++ks) { const size_t o = (size_t)(g * S5C + cc) * S5P + 16 * ks + 4 * kq;
            const f32x4 cr4 = *(const f32x4*)(c_re + o), ci4 = *(const f32x4*)(c_im + o);
            v4u wv; wv.x = pk2(cr4.x, -ci4.x); wv.y = pk2(cr4.y, -ci4.y); wv.z = pk2(cr4.z, -ci4.z); wv.w = pk2(cr4.w, -ci4.w); Cf[ks] = __builtin_bit_cast(bf16x8, wv); }
        const f32x4 d4 = *(const f32x4*)(dsk + g * S5C + 4 * kq);
        const f32x4 gq = *(const f32x4*)(gain + g * S5C + 4 * (lane & 3));
        float sr[2] = {0.f, 0.f}, si[2] = {0.f, 0.f};
        if (seg < 3) s5_run<false>(x, rs0, G, U, Sim, g, bp, seg * SEGT, SEGT, lane, Bf, Cf, lr, li, d4, gq, sr, si);
#pragma unroll
        for (int q = 0; q < 2; ++q) { E[((w * 2 + q) * 2 + 0) * 64 + lane] = sr[q]; E[((w * 2 + q) * 2 + 1) * 64 + lane] = si[q]; }
        __syncthreads();
        sr[0] = sr[1] = si[0] = si[1] = 0.f;
        for (int j = 0; j < seg; ++j) {
#pragma unroll
            for (int q = 0; q < 2; ++q) { const float er = E[(((bp * 4 + j) * 2 + q) * 2 + 0) * 64 + lane], ei = E[(((bp * 4 + j) * 2 + q) * 2 + 1) * 64 + lane];
                const float nr = Lr[q] * sr[q] - Li[q] * si[q] + er, ni = Lr[q] * si[q] + Li[q] * sr[q] + ei; sr[q] = nr; si[q] = ni; }
        }
        s5_run<true>(x, rs0, G, U, Sim, g, bp, seg * SEGT, SEGT, lane, Bf, Cf, lr, li, d4, gq, sr, si);
        __syncthreads();
    }
}

template <int MODE>
__device__ __forceinline__ void resid_phase(Frame& F, const bf16* __restrict__ mb, const float* __restrict__ xin, bf16* hb, float* __restrict__ outp, float* rms, const float* __restrict__ gain) {
    refresh(F);
    const int gw = F.vcu * NWAVES + F.wave, NGW = F.G * NWAVES, lane = F.lane;
    LAS float* gl = (LAS float*)(F.lds + RING_OFF);
    for (int i = F.tid; i < D / 4; i += NWAVES * 64) *(LAS f32x4*)(gl + 4 * i) = *(const f32x4*)(gain + 4 * i);
    __syncthreads();
    for (int m = gw; m < M; m += NGW) {
        v4u mv[8]; f32x4 hx[MODE == 0 ? 8 : 1][2]; v4u hq[MODE == 0 ? 1 : 8];
        const float rp = (MODE == 0) ? 1.0f : rms[m];
#pragma unroll
        for (int j = 0; j < 8; ++j) { const size_t o = (size_t)m * D + j * 512 + lane * 8; mv[j] = *(const GAS v4u*)(mb + o);
            if (MODE == 0) { hx[j % (MODE == 0 ? 8 : 1)][0] = *(const GAS f32x4*)(xin + o); hx[j % (MODE == 0 ? 8 : 1)][1] = *(const GAS f32x4*)(xin + o + 4); }
            else hq[j % (MODE == 0 ? 1 : 8)] = *(const GAS v4u*)(hb + o); }
        float s = 0.f;
#pragma unroll
        for (int j = 0; j < 8; ++j) { const float a0 = bf_lo(mv[j].x), a1 = bf_hi(mv[j].x), a2 = bf_lo(mv[j].y), a3 = bf_hi(mv[j].y), a4 = bf_lo(mv[j].z), a5 = bf_hi(mv[j].z), a6 = bf_lo(mv[j].w), a7 = bf_hi(mv[j].w);
            s += (a0 * a0 + a1 * a1) + (a2 * a2 + a3 * a3) + (a4 * a4 + a5 * a5) + (a6 * a6 + a7 * a7); }
        s = wave_sum(s);
        const float rm = 1.0f / sqrtf(s * (1.0f / D) + EPS);
        float s2 = 0.f;
        f32x4 hn[MODE == 2 ? 1 : 8][2];
#pragma unroll
        for (int j = 0; j < 8; ++j) { const size_t o = (size_t)m * D + j * 512 + lane * 8;
            const f32x4 g0 = *(const LAS f32x4*)(gl + j * 512 + lane * 8), g1 = *(const LAS f32x4*)(gl + j * 512 + lane * 8 + 4);
            const f32x4 m0 = {bf_lo(mv[j].x), bf_hi(mv[j].x), bf_lo(mv[j].y), bf_hi(mv[j].y)}, m1 = {bf_lo(mv[j].z), bf_hi(mv[j].z), bf_lo(mv[j].w), bf_hi(mv[j].w)};
            f32x4 p0, p1;
            if (MODE == 0) { p0 = hx[j % (MODE == 0 ? 8 : 1)][0]; p1 = hx[j % (MODE == 0 ? 8 : 1)][1]; }
            else { const v4u t = hq[j % (MODE == 0 ? 1 : 8)]; p0 = (f32x4){bf_lo(t.x), bf_hi(t.x), bf_lo(t.y), bf_hi(t.y)} * rp; p1 = (f32x4){bf_lo(t.z), bf_hi(t.z), bf_lo(t.w), bf_hi(t.w)} * rp; }
            const f32x4 h0 = p0 + m0 * rm * g0, h1 = p1 + m1 * rm * g1;
            if (MODE == 2) { *(GAS f32x4*)(outp + o) = h0; *(GAS f32x4*)(outp + o + 4) = h1; }
            else { s2 += (h0.x * h0.x + h0.y * h0.y) + (h0.z * h0.z + h0.w * h0.w) + (h1.x * h1.x + h1.y * h1.y) + (h1.z * h1.z + h1.w * h1.w);
                hn[j % (MODE == 2 ? 1 : 8)][0] = h0; hn[j % (MODE == 2 ? 1 : 8)][1] = h1; }
        }
        if (MODE != 2) { s2 = wave_sum(s2); const float ms = s2 * (1.0f / D) + EPS; const float rh = 1.0f / sqrtf(ms);
            if (lane == 0) rms[m] = sqrtf(ms);
#pragma unroll
            for (int j = 0; j < 8; ++j) { const size_t o = (size_t)m * D + j * 512 + lane * 8; const f32x4 h0 = hn[j % (MODE == 2 ? 1 : 8)][0] * rh, h1 = hn[j % (MODE == 2 ? 1 : 8)][1] * rh;
                v4u w; w.x = pk2(h0.x, h0.y); w.y = pk2(h0.z, h0.w); w.z = pk2(h1.x, h1.y); w.w = pk2(h1.z, h1.w); *(GAS v4u*)(hb + o) = w; } }
    }
    __syncthreads();
}

constexpr int AK_ROW = 144, AV_ROW = 528;
constexpr int AK_OFF = 0, AV_OFF = 256 * AK_ROW;
__device__ __forceinline__ void attn_phase(Frame& F) {
    refresh(F);
    const KArgs A_ = kargs();
    const bf16* Q = (const bf16*)(A_->ws + WS_Q); const bf16* Kg = (const bf16*)(A_->ws + WS_K); const bf16* Vg = (const bf16*)(A_->ws + WS_V); bf16* O = (bf16*)(A_->ws + WS_GA);
    const float* sinks = (const float*)A_->in[22];
    LAS unsigned char* Ks = F.lds + RING_OFF + AK_OFF; LAS unsigned char* Vt = F.lds + RING_OFF + AV_OFF;
    const int tid = F.tid, lane = F.lane, col = lane & 31, h = lane >> 5;
    constexpr float SC = 0.125f * 1.4426950408889634f;
    for (int unit = F.vcu; unit < NB * 8 * 32; unit += F.G) {
        const int b = unit >> 8, kvh = (unit >> 5) & 7, qblk = unit & 31;
        const int key0 = 128 * (qblk - 1);
        __syncthreads();
#pragma unroll
        for (int i = 0; i < 4; ++i) { const int t = tid + 512 * i, kr = t >> 3, c = t & 7; const int ks = key0 + kr;
            v4u v = {0u, 0u, 0u, 0u}; if (ks >= 0) v = *(const GAS v4u*)(Kg + (size_t)(b * SEQ + ks) * 512 + kvh * 64 + 8 * c);
            *(LAS v4u*)(Ks + kr * AK_ROW + 16 * c) = v; }
#pragma unroll
        for (int i = 0; i < 2; ++i) { const int t = tid + 512 * i, kp = t & 127, c = t >> 7; const int ka = 2 * kp, ks = key0 + ka;
            v4u va = {0u, 0u, 0u, 0u}, vb = {0u, 0u, 0u, 0u};
            if (ks >= 0) { va = *(const GAS v4u*)(Vg + (size_t)(b * SEQ + ks) * 512 + kvh * 64 + 8 * c); vb = *(const GAS v4u*)(Vg + (size_t)(b * SEQ + ks + 1) * 512 + kvh * 64 + 8 * c); }
            const int kap = ka & 15, pos = (ka & ~15) + 8 * ((kap >> 2) & 1) + 4 * (kap >> 3) + (kap & 3);
            LAS unsigned char* dst = Vt + (8 * c) * AV_ROW + pos * 2;
            *(LAS unsigned*)(dst + 0 * AV_ROW) = (va.x & 0xffffu) | (vb.x << 16); *(LAS unsigned*)(dst + 1 * AV_ROW) = (va.x >> 16) | (vb.x & 0xffff0000u);
            *(LAS unsigned*)(dst + 2 * AV_ROW) = (va.y & 0xffffu) | (vb.y << 16); *(LAS unsigned*)(dst + 3 * AV_ROW) = (va.y >> 16) | (vb.y & 0xffff0000u);
            *(LAS unsigned*)(dst + 4 * AV_ROW) = (va.z & 0xffffu) | (vb.z << 16); *(LAS unsigned*)(dst + 5 * AV_ROW) = (va.z >> 16) | (vb.z & 0xffff0000u);
            *(LAS unsigned*)(dst + 6 * AV_ROW) = (va.w & 0xffffu) | (vb.w << 16); *(LAS unsigned*)(dst + 7 * AV_ROW) = (va.w >> 16) | (vb.w & 0xffff0000u); }
        __syncthreads();
        const int head = kvh * 8 + F.wave;
        const float sink2 = sinks[head] * 1.4426950408889634f;
#pragma unroll 1
        for (int qs = 0; qs < 4; ++qs) {
            const size_t qrow = (size_t)(b * SEQ + 128 * qblk + 32 * qs + col);
            bf16x8 qf[4];
#pragma unroll
            for (int s4 = 0; s4 < 4; ++s4) qf[s4] = *(const GAS bf16x8*)(Q + qrow * D + head * 64 + 16 * s4 + 8 * h);
            f32x16 sc[5];
#pragma unroll
            for (int t = 0; t < 5; ++t) {
#pragma unroll
                for (int r = 0; r < 16; ++r) sc[t][r] = 0.f;
#pragma unroll
                for (int s4 = 0; s4 < 4; ++s4) { const bf16x8 kf = *(const LAS bf16x8*)(Ks + (32 * (qs + t) + col) * AK_ROW + (16 * s4 + 8 * h) * 2);
                    sc[t] = __builtin_amdgcn_mfma_f32_32x32x16_bf16(kf, qf[s4], sc[t], 0, 0, 0); }
            }
            float mloc = -1e30f;
#pragma unroll
            for (int t = 0; t < 5; ++t) { const bool tile_ok = (qblk > 0) || (qs + t >= 4);
#pragma unroll
                for (int r = 0; r < 16; ++r) { const int row = (r & 3) + 8 * (r >> 2) + 4 * h;
                    bool ok = tile_ok; if (t == 0) ok = ok && (row > col); if (t == 4) ok = ok && (row <= col);
                    const float v = ok ? sc[t][r] * SC : -1e30f; sc[t][r] = v; mloc = fmaxf(mloc, v); } }
            float m2 = fmaxf(mloc, __shfl_xor(mloc, 32)); m2 = fmaxf(m2, sink2);
            float lloc = 0.f;
#pragma unroll
            for (int t = 0; t < 5; ++t)
#pragma unroll
                for (int r = 0; r < 16; ++r) { const float p = __builtin_amdgcn_exp2f(sc[t][r] - m2); sc[t][r] = p; lloc += p; }
            const float l = lloc + __shfl_xor(lloc, 32) + __builtin_amdgcn_exp2f(sink2 - m2);
            f32x16 o[2];
#pragma unroll
            for (int r = 0; r < 16; ++r) { o[0][r] = 0.f; o[1][r] = 0.f; }
#pragma unroll
            for (int t = 0; t < 5; ++t)
#pragma unroll
                for (int s2 = 0; s2 < 2; ++s2) {
                    v4u pw; pw.x = pk2(sc[t][8 * s2 + 0], sc[t][8 * s2 + 1]); pw.y = pk2(sc[t][8 * s2 + 2], sc[t][8 * s2 + 3]); pw.z = pk2(sc[t][8 * s2 + 4], sc[t][8 * s2 + 5]); pw.w = pk2(sc[t][8 * s2 + 6], sc[t][8 * s2 + 7]);
                    const bf16x8 pb = __builtin_bit_cast(bf16x8, pw);
#pragma unroll
                    for (int db = 0; db < 2; ++db) { const bf16x8 vf = *(const LAS bf16x8*)(Vt + (32 * db + col) * AV_ROW + (32 * (qs + t) + 16 * s2 + 8 * h) * 2);
                        o[db] = __builtin_amdgcn_mfma_f32_32x32x16_bf16(vf, pb, o[db], 0, 0, 0); }
                }
            const float inv = 1.0f / l;
#pragma unroll
            for (int db = 0; db < 2; ++db)
#pragma unroll
                for (int g4 = 0; g4 < 4; ++g4) { v2u w; w.x = pk2(o[db][4 * g4] * inv, o[db][4 * g4 + 1] * inv); w.y = pk2(o[db][4 * g4 + 2] * inv, o[db][4 * g4 + 3] * inv);
                    *(GAS v2u*)(O + qrow * D + head * 64 + 32 * db + 8 * g4 + 4 * h) = w; }
        }
    }
    __syncthreads();
}

#define GEMM_PHASE(EPI, Aptr, Wptr, NN, KK, ...) GEMM_PHASE_G(EPI, pg8::WGM, Aptr, Wptr, NN, KK, __VA_ARGS__)
#define GEMM_PHASE_G(EPI, WG, Aptr, Wptr, NN, KK, ...) do { pg8::Gemm g{(const bf16*)(Aptr), (const bf16*)(Wptr), M, NN, KK}; pg8::StaticOrder S; S.init(M, NN, F.G, (int)blockIdx.x, WG); \
        pg8::EPI E{__VA_ARGS__}; pg8::gemm_phase<pg8::EPI, pg8::StaticOrder, true, true>(F.lds + RING_OFF, g, S, E); } while (0)
__global__ void __launch_bounds__(NWAVES * 64, 2) fwd(Args args_unused) {
    extern __shared__ __attribute__((aligned(16))) unsigned char lds[];
    Frame F;
    F.lds = (LAS unsigned char*)lds;
    F.tid = threadIdx.x; F.lane = F.tid & 63; F.wave = __builtin_amdgcn_readfirstlane(F.tid >> 6);
    F.G = gridDim.x; { const int bx = blockIdx.x; F.vcu = (F.G % 8 == 0) ? (bx % 8) * (F.G / 8) + bx / 8 : bx; }
    for (int u = F.tid; u < (LDS_BYTES - LDSCTL_OFF) / 4; u += NWAVES * 64) ((LAS unsigned*)(F.lds + LDSCTL_OFF))[u] = 0u;
    __syncthreads();
    XcdBarrier bar = xcd_barrier_post((unsigned*)(kargs()->ws + WS_CTL) + CW_BAR, (volatile LAS unsigned*)(F.lds + MISC_OFF) + 8);
#define WSP(off) (kargs()->ws + (off))
#define RSP(i) ((float*)(kargs()->ws + WS_RS) + (size_t)(i) * M)
#define INF(i) ((const float*)kargs()->in[i])

    p0_prologue(F); xcd_barrier(bar);
    s5_phase(F); xcd_barrier(bar);
    GEMM_PHASE(EpiGlu, WSP(WS_GA), WSP(WS_WGLU), NGLU, D, (bf16*)WSP(WS_MB), D, INF(15), INF(17)); xcd_barrier(bar);
    { const KArgs a = kargs(); resid_phase<0>(F, (const bf16*)(a->ws + WS_MB), (const float*)a->in[0], (bf16*)(a->ws + WS_HB), nullptr, (float*)(a->ws + WS_RS) + M, (const float*)a->in[3]); } xcd_barrier(bar);
    GEMM_PHASE(EpiSwiglu, WSP(WS_HB), WSP(WS_WUP0), NUP, D, (bf16*)WSP(WS_ACT), FF);
    { const int nwg = (M / 256) * (NUP / 256), rem = nwg % (int)gridDim.x;
      if (rem == 0) p0_dn_tail(F, 0, (int)blockIdx.x, (int)gridDim.x); else if ((int)blockIdx.x >= rem) p0_dn_tail(F, 0, (int)blockIdx.x - rem, (int)gridDim.x - rem); }
    xcd_barrier(bar);
    GEMM_PHASE_G(EpiPlain, 2, WSP(WS_ACT), WSP(WS_WDN0), D, FF, (bf16*)WSP(WS_MB), D, nullptr); xcd_barrier(bar);
    { const KArgs a = kargs(); resid_phase<1>(F, (const bf16*)(a->ws + WS_MB), nullptr, (bf16*)(a->ws + WS_HB), nullptr, (float*)(a->ws + WS_RS) + M, (const float*)a->in[5]); } xcd_barrier(bar);
    GEMM_PHASE(EpiQkv, WSP(WS_HB), WSP(WS_WQKV), NQKV, D, (bf16*)WSP(WS_Q), (bf16*)WSP(WS_K), (bf16*)WSP(WS_V), INF(19), (const int*)kargs()->in[1]); xcd_barrier(bar);
    attn_phase(F); xcd_barrier(bar);
    GEMM_PHASE(EpiPlain, WSP(WS_GA), WSP(WS_WO), D, D, (bf16*)WSP(WS_MB), D, INF(21)); xcd_barrier(bar);
    { const KArgs a = kargs(); resid_phase<1>(F, (const bf16*)(a->ws + WS_MB), nullptr, (bf16*)(a->ws + WS_HB), nullptr, (float*)(a->ws + WS_RS) + M, (const float*)a->in[3] + D); } xcd_barrier(bar);
    GEMM_PHASE(EpiSwiglu, WSP(WS_HB), WSP(WS_WUP1), NUP, D, (bf16*)WSP(WS_ACT), FF);
    { const int nwg = (M / 256) * (NUP / 256), rem = nwg % (int)gridDim.x;
      if (rem == 0) p0_dn_tail(F, 1, (int)blockIdx.x, (int)gridDim.x); else if ((int)blockIdx.x >= rem) p0_dn_tail(F, 1, (int)blockIdx.x - rem, (int)gridDim.x - rem); }
    xcd_barrier(bar);
    GEMM_PHASE_G(EpiPlain, 2, WSP(WS_ACT), WSP(WS_WDN1), D, FF, (bf16*)WSP(WS_MB), D, nullptr); xcd_barrier(bar);
    { const KArgs a = kargs(); resid_phase<2>(F, (const bf16*)(a->ws + WS_MB), nullptr, (bf16*)(a->ws + WS_HB), a->out, (float*)(a->ws + WS_RS) + M, (const float*)a->in[5] + D); }
}

extern "C" void kernel_launch(void* const* d_in, const int* in_sizes, int n_in, void* d_out, int out_size, void* d_ws, size_t ws_size, hipStream_t stream) {
    static int grid = 0;
    if (grid == 0) {
        if (n_in != 26 || in_sizes[0] != M * D || out_size != M * D || ws_size < WS_END) { fprintf(stderr, "kernel_launch: unexpected shapes (n_in %d, in0 %d, out %d, ws %zu); nothing launched\n", n_in, n_in > 0 ? in_sizes[0] : -1, out_size, ws_size); grid = -1; return; }
        int dev = 0, cus = 0, per_cu = 0;
        if (hipGetDevice(&dev) != hipSuccess || hipDeviceGetAttribute(&cus, hipDeviceAttributeMultiprocessorCount, dev) != hipSuccess) { grid = -1; return; }
        if (hipFuncSetAttribute((const void*)fwd, hipFuncAttributeMaxDynamicSharedMemorySize, LDS_BYTES) != hipSuccess) { fprintf(stderr, "kernel_launch: hipFuncSetAttribute failed\n"); grid = -1; return; }
        if (hipOccupancyMaxActiveBlocksPerMultiprocessor(&per_cu, (const void*)fwd, NWAVES * 64, LDS_BYTES) != hipSuccess || per_cu < 1)
            fprintf(stderr, "kernel_launch: note: occupancy query reports %d workgroups per CU\n", per_cu);
        (void)hipGetLastError();
        grid = cus;
    }
    if (grid < 0) return;
    if (hipMemsetAsync((char*)d_ws + WS_CTL, 0, CTL_ZERO_BYTES, stream) != hipSuccess) { fprintf(stderr, "kernel_launch: hipMemsetAsync failed\n"); return; }
    Args a{};
    for (int i = 0; i < 26; ++i) a.in[i] = d_in[i];
    a.out = (float*)d_out; a.ws = (unsigned char*)d_ws;
    hipLaunchKernelGGL(fwd, dim3(grid), dim3(NWAVES * 64), LDS_BYTES, stream, a);
    const hipError_t le = hipPeekAtLastError();
    if (le != hipSuccess) fprintf(stderr, "kernel_launch: launch failed: %s\n", hipGetErrorName(le));
}
```
